# Optimizing an MI355X kernel written in HIP

```python
import math
import jax
import jax.numpy as jnp
from jax import lax
import numpy as np

D_MODEL = 1024
BATCH = 8
SEQ = 4096
DEPTH = 4

GRID_W = 64
CTX_LEN = 256
N_EVEN = (DEPTH + 1) // 2
N_ODD = DEPTH // 2
EPS = 1e-6
CONV_W = 4
LRU_WIDTH = D_MODEL // 2
LRU_BLOCKS = 8
LRU_BLOCK = LRU_WIDTH // LRU_BLOCKS
LRU_C = 8.0
RET_HEADS = 4
RET_DK = D_MODEL // 16
RET_DV = D_MODEL // 8
RET_CHUNK = 128
ROPE_BASE = 10000.0
HG_HEADS = 4
HG_DK = D_MODEL // 8
HG_DV = D_MODEL // 8
GDN_HEADS = 4
GDN_DK = D_MODEL // 8
GDN_DV = D_MODEL // 8
LIN_CHUNK = 64
D_FF = 4 * D_MODEL
EV_SIZES = (LRU_WIDTH, LRU_WIDTH, RET_HEADS * RET_DK, RET_HEADS * RET_DK, RET_HEADS * RET_DV, RET_HEADS * RET_DV)
OD_SIZES = (HG_HEADS * HG_DK, HG_HEADS * HG_DK, HG_HEADS * HG_DK, HG_HEADS * HG_DV, HG_HEADS * HG_DV,
            GDN_HEADS * GDN_DK, GDN_HEADS * GDN_DK, GDN_HEADS * GDN_DV, GDN_HEADS * GDN_DV, 2 * GDN_HEADS, 2 * GDN_HEADS)
EV_IN = sum(EV_SIZES)
OD_IN = sum(OD_SIZES)
MIX_WIDTH = LRU_WIDTH + RET_HEADS * RET_DV
F32 = jnp.float32

kernel_name = 'hybrid_bidir_rglru_retention_hgrn2_gdn'


def _rmsnorm(x, g):
    xf = x.astype(F32)
    y = xf * lax.rsqrt(jnp.mean(xf * xf, axis=-1, keepdims=True) + EPS)
    return (y * g.astype(F32)).astype(x.dtype)


def _modulate(h, shift, scale):
    return h * (1.0 + scale) + shift


def _split(t, sizes):
    return jnp.split(t, np.cumsum(sizes)[:-1].tolist(), axis=-1)


def _heads(t, n_heads):
    return t.reshape(t.shape[:-1] + (n_heads, t.shape[-1] // n_heads))


def _dwconv(t, w):
    left = CONV_W // 2
    return lax.conv_general_dilated(t, w.astype(t.dtype)[:, None, :], window_strides=(1,),
                                    padding=[(left, CONV_W - 1 - left)],
                                    dimension_numbers=('NWC', 'WIO', 'NWC'),
                                    feature_group_count=t.shape[-1])


def _l2norm(t):
    t = t.astype(F32)
    return t * lax.rsqrt(jnp.sum(t * t, axis=-1, keepdims=True) + EPS)


def _head_rms(o):
    o = o.astype(F32)
    o = o * lax.rsqrt(jnp.mean(o * o, axis=-1, keepdims=True) + EPS)
    return o.reshape(o.shape[0], o.shape[1], -1)


def _head_groupnorm(o):
    o = o.astype(F32)
    o = o - jnp.mean(o, axis=-1, keepdims=True)
    return _head_rms(o)


def _scan_order(ctx_part, lat_part, reverse):
    if reverse:
        ctx_part, lat_part = jnp.flip(ctx_part, 1), jnp.flip(lat_part, 1)
    return jnp.concatenate([ctx_part, lat_part], axis=1)


def _natural_order(y, n_ctx, reverse):
    if not reverse:
        return y
    return jnp.concatenate([jnp.flip(y[:, :n_ctx], 1), jnp.flip(y[:, n_ctx:], 1)], axis=1)


def _blk(t, chunk):
    b, l = t.shape[0], t.shape[1]
    t = t.astype(F32).reshape((b, l // chunk, chunk) + t.shape[2:])
    return jnp.moveaxis(t, 3, 2)


def _unblk(t):
    b, n, h, c, d = t.shape
    return jnp.moveaxis(t, 2, 3).reshape(b, n * c, h, d)


def _masked_exp(mask, logits):
    return jnp.where(mask, jnp.exp(jnp.where(mask, logits, 0.0)), 0.0)


def _linear_scan(a, b):
    def comb(l, r):
        return l[0] * r[0], r[0] * l[1] + r[1]
    _, h = lax.associative_scan(comb, (a, b), axis=1)
    return h


def _axial_rope(rows):
    n_freq = RET_DK // 4
    inv = jnp.power(ROPE_BASE, -jnp.arange(n_freq, dtype=F32) / n_freq)
    r = jnp.arange(rows, dtype=F32)
    col = jnp.arange(GRID_W, dtype=F32)
    row_ang = jnp.broadcast_to(r[:, None, None] * inv, (rows, GRID_W, n_freq))
    col_ang = jnp.broadcast_to(col[None, :, None] * inv, (rows, GRID_W, n_freq))
    ang = jnp.concatenate([row_ang, col_ang], axis=-1).reshape(rows * GRID_W, 2 * n_freq)
    return jnp.cos(ang), jnp.sin(ang)


def _rope(x, cos, sin):
    half = x.shape[-1] // 2
    xf = x.astype(F32)
    x1, x2 = xf[..., :half], xf[..., half:]
    c, s = cos[None, :, None, :], sin[None, :, None, :]
    return jnp.concatenate([x1 * c - x2 * s, x1 * s + x2 * c], axis=-1).astype(x.dtype)


def _retention_chunked(q, k, v, log_gamma, chunk):
    qb, kb, vb = _blk(q, chunk), _blk(k, chunk), _blk(v, chunk)
    b, n, h, c, dk = qb.shape
    dv = vb.shape[-1]
    pos = jnp.arange(c, dtype=F32)
    diff = pos[:, None] - pos[None, :]
    lg = log_gamma.astype(F32)
    decay_in = jnp.where(diff >= 0, jnp.exp(lg[:, None, None] * jnp.maximum(diff, 0.0)), 0.0)
    q_dec = jnp.exp(lg[:, None] * (pos + 1.0))
    k_dec = jnp.exp(lg[:, None] * (c - 1.0 - pos))
    c_dec = jnp.exp(lg * c)
    inner = jnp.einsum('bnhid,bnhjd->bnhij', qb, kb) * decay_in
    o_in = jnp.einsum('bnhij,bnhjv->bnhiv', inner, vb)

    def step(state, inp):
        q_c, kd_c, v_c = inp
        o_x = jnp.einsum('bhid,bhdv->bhiv', q_c, state) * q_dec[..., None]
        state = state * c_dec[:, None, None] + jnp.einsum('bhjd,bhjv->bhdv', kd_c, v_c)
        return state, o_x

    xs = (jnp.moveaxis(qb, 1, 0), jnp.moveaxis(kb * k_dec[..., None], 1, 0), jnp.moveaxis(vb, 1, 0))
    _, o_x = lax.scan(step, jnp.zeros((b, h, dk, dv), F32), xs)
    return _unblk(o_in + jnp.moveaxis(o_x, 0, 1))


def _gla_chunked(q, k, v, logf, chunk):
    qb, kb, vb = _blk(q, chunk), _blk(k, chunk), _blk(v, chunk)
    ab = jnp.cumsum(_blk(logf, chunk), axis=3)
    b, n, h, c, dk = qb.shape
    dv = vb.shape[-1]
    causal = jnp.tril(jnp.ones((c, c), dtype=bool))[:, :, None]

    def step(state, inp):
        q_c, k_c, v_c, a_c = inp
        dec = _masked_exp(causal, a_c[:, :, :, None, :] - a_c[:, :, None, :, :])
        scores = jnp.einsum('bhid,bhjd,bhijd->bhij', q_c, k_c, dec)
        a_last = a_c[:, :, -1, :]
        o = (jnp.einsum('bhij,bhjv->bhiv', scores, v_c)
             + jnp.einsum('bhid,bhdv->bhiv', q_c * jnp.exp(a_c), state))
        state = (state * jnp.exp(a_last)[..., None]
                 + jnp.einsum('bhjd,bhjv->bhdv', k_c * jnp.exp(a_last[:, :, None, :] - a_c), v_c))
        return state, o

    xs = tuple(jnp.moveaxis(t, 1, 0) for t in (qb, kb, vb, ab))
    _, o = lax.scan(step, jnp.zeros((b, h, dk, dv), F32), xs)
    return _unblk(jnp.moveaxis(o, 0, 1))


def _gated_delta_chunked(q, k, v, beta, g, chunk):
    qb, kb, vb = _blk(q, chunk), _blk(k, chunk), _blk(v, chunk)
    bb = _blk(beta, chunk)
    gc = jnp.cumsum(_blk(g, chunk), axis=-1)
    b, n, h, c, dk = qb.shape
    dv = vb.shape[-1]
    causal = jnp.tril(jnp.ones((c, c), dtype=bool))
    strict = jnp.tril(jnp.ones((c, c), dtype=bool), k=-1)
    gam = _masked_exp(causal, gc[..., :, None] - gc[..., None, :])
    kbeta = kb * bb[..., None]
    m = jnp.where(strict, jnp.einsum('bnhid,bnhjd->bnhij', kbeta, kb) * gam, 0.0)
    rhs = jnp.concatenate([vb * bb[..., None], kbeta * jnp.exp(gc)[..., None]], axis=-1)
    sol = lax.linalg.triangular_solve(m + jnp.eye(c, dtype=F32), rhs, left_side=True, lower=True,
                                      unit_diagonal=True)
    u, w = sol[..., :dv], sol[..., dv:]
    qk = jnp.einsum('bnhid,bnhjd->bnhij', qb, kb) * gam
    q_dec = qb * jnp.exp(gc)[..., None]
    k_dec = kb * jnp.exp(gc[..., -1:] - gc)[..., None]
    g_last = jnp.exp(gc[..., -1])

    def step(state, inp):
        u_c, w_c, qk_c, qd_c, kd_c, gl_c = inp
        v_new = u_c - jnp.einsum('bhcd,bhdv->bhcv', w_c, state)
        o = jnp.einsum('bhcd,bhdv->bhcv', qd_c, state) + jnp.einsum('bhij,bhjv->bhiv', qk_c, v_new)
        state = state * gl_c[..., None, None] + jnp.einsum('bhcd,bhcv->bhdv', kd_c, v_new)
        return state, o

    xs = tuple(jnp.moveaxis(t, 1, 0) for t in (u, w, qk, q_dec, k_dec, g_last))
    _, o = lax.scan(step, jnp.zeros((b, h, dk, dv), F32), xs)
    return _unblk(jnp.moveaxis(o, 0, 1))


def _even_mixer(hc, hl, w_in, conv_w, conv_b, wa, ba, wx, bx, lam, log_gamma, cos, sin):
    n_ctx = hc.shape[1]
    bsz = hl.shape[0]
    xc, gc, qc, kc, vc, zc = _split(hc @ w_in, EV_SIZES)
    xl, gl, ql, kl, vl, zl = _split(hl @ w_in, EV_SIZES)
    uc = _dwconv(xc, conv_w) + conv_b
    ul = _dwconv(xl, conv_w) + conv_b
    h = 0.0
    for d, rev in enumerate((False, True)):
        u = _scan_order(uc, ul, rev)
        seq_len = u.shape[1]
        ub = u.reshape(bsz, seq_len, LRU_BLOCKS, LRU_BLOCK)
        r = jax.nn.sigmoid((jnp.einsum('blki,kij->blkj', ub, wa[d]).reshape(bsz, seq_len, LRU_WIDTH) + ba[d]).astype(F32))
        i = jax.nn.sigmoid((jnp.einsum('blki,kij->blkj', ub, wx[d]).reshape(bsz, seq_len, LRU_WIDTH) + bx[d]).astype(F32))
        log_a = -LRU_C * jax.nn.softplus(-lam[d].astype(F32)) * r
        inp = jnp.sqrt(-jnp.expm1(2.0 * log_a)) * (i * u.astype(F32))
        h = h + _natural_order(_linear_scan(jnp.exp(log_a), inp), n_ctx, rev)
    y_a = h * jax.nn.gelu(jnp.concatenate([gc, gl], axis=1).astype(F32))
    qk_scale = RET_DK ** -0.5
    qc, kc, vc = _heads(qc, RET_HEADS), _heads(kc, RET_HEADS) * qk_scale, _heads(vc, RET_HEADS)
    ql = _rope(_heads(ql, RET_HEADS), cos, sin)
    kl = _rope(_heads(kl, RET_HEADS), cos, sin) * qk_scale
    vl = _heads(vl, RET_HEADS)
    o = 0.0
    for d, rev in enumerate((False, True)):
        o_d = _retention_chunked(_scan_order(qc, ql, rev), _scan_order(kc, kl, rev),
                                 _scan_order(vc, vl, rev), log_gamma[d], RET_CHUNK)
        o = o + _natural_order(o_d, n_ctx, rev)
    y_b = _head_groupnorm(o) * jax.nn.silu(jnp.concatenate([zc, zl], axis=1).astype(F32))
    return jnp.concatenate([y_a, y_b], axis=-1).astype(hl.dtype)


def _odd_mixer(hc, hl, w_in, lb, conv_w, a_log, dt_bias):
    n_ctx = hc.shape[1]
    (hq_c, ff_c, fb_c, hi_c, hz_c, gq_c, gk_c, gv_c, gz_c, gb_c, ga_c) = _split(hc @ w_in, OD_SIZES)
    (hq_l, ff_l, fb_l, hi_l, hz_l, gq_l, gk_l, gv_l, gz_l, gb_l, ga_l) = _split(hl @ w_in, OD_SIZES)
    q_c, q_l = _heads(jax.nn.silu(hq_c), HG_HEADS), _heads(jax.nn.silu(hq_l), HG_HEADS)
    i_c, i_l = _heads(hi_c, HG_HEADS), _heads(hi_l, HG_HEADS)
    o = 0.0
    for d, rev in enumerate((False, True)):
        fpre = _scan_order(ff_c, ff_l, rev) if d == 0 else _scan_order(fb_c, fb_l, rev)
        lbd = lb[d]
        f = lbd + (1.0 - lbd) * jax.nn.sigmoid(fpre.astype(F32))
        logf = _heads(jnp.log(f), HG_HEADS)
        o_d = _gla_chunked(_scan_order(q_c, q_l, rev), _heads(1.0 - f, HG_HEADS), _scan_order(i_c, i_l, rev),
                           logf, LIN_CHUNK)
        o = o + _natural_order(o_d, n_ctx, rev)
    y_c = _head_rms(o) * jax.nn.silu(jnp.concatenate([hz_c, hz_l], axis=1).astype(F32))
    qkv_c = jax.nn.silu(_dwconv(jnp.concatenate([gq_c, gk_c, gv_c], axis=-1), conv_w))
    qkv_l = jax.nn.silu(_dwconv(jnp.concatenate([gq_l, gk_l, gv_l], axis=-1), conv_w))
    dq_c, dk_c, dv_c = _split(qkv_c, (GDN_HEADS * GDN_DK, GDN_HEADS * GDN_DK, GDN_HEADS * GDN_DV))
    dq_l, dk_l, dv_l = _split(qkv_l, (GDN_HEADS * GDN_DK, GDN_HEADS * GDN_DK, GDN_HEADS * GDN_DV))
    q_scale = GDN_DK ** -0.5
    dq_c, dq_l = _l2norm(_heads(dq_c, GDN_HEADS)) * q_scale, _l2norm(_heads(dq_l, GDN_HEADS)) * q_scale
    dk_c, dk_l = _l2norm(_heads(dk_c, GDN_HEADS)), _l2norm(_heads(dk_l, GDN_HEADS))
    dv_c, dv_l = _heads(dv_c, GDN_HEADS), _heads(dv_l, GDN_HEADS)
    o = 0.0
    for d, rev in enumerate((False, True)):
        sl = slice(d * GDN_HEADS, (d + 1) * GDN_HEADS)
        beta = jax.nn.sigmoid(_scan_order(gb_c[..., sl], gb_l[..., sl], rev).astype(F32))
        a_pre = _scan_order(ga_c[..., sl], ga_l[..., sl], rev).astype(F32)
        g = -jnp.exp(a_log[d].astype(F32)) * jax.nn.softplus(a_pre + dt_bias[d].astype(F32))
        o_d = _gated_delta_chunked(_scan_order(dq_c, dq_l, rev), _scan_order(dk_c, dk_l, rev),
                                   _scan_order(dv_c, dv_l, rev), beta, g, LIN_CHUNK)
        o = o + _natural_order(o_d, n_ctx, rev)
    y_d = _head_rms(o) * jax.nn.silu(jnp.concatenate([gz_c, gz_l], axis=1).astype(F32))
    return jnp.concatenate([y_c, y_d], axis=-1).astype(hl.dtype)


def _sqrelu_mlp(h, w1, w2):
    return jnp.square(jax.nn.relu(h @ w1)) @ w2


def setup_inputs(seed: int = 0) -> dict:
    key = jax.random.key(seed)
    keys = iter(jax.random.split(key, 40))

    def nrm(shape, std):
        return jax.random.normal(next(keys), shape, F32) * std

    def unif(shape, lo, hi):
        return jax.random.uniform(next(keys), shape, F32, lo, hi)

    x = nrm((BATCH, SEQ, D_MODEL), 1.0)
    c = nrm((BATCH, D_MODEL), 1.0)
    ctx = nrm((BATCH, CTX_LEN, D_MODEL), 1.0)
    c_ctx = nrm((D_MODEL,), 1.0)
    ada_w = nrm((DEPTH, D_MODEL, 6 * D_MODEL), 0.5 * D_MODEL ** -0.5)
    ada_b = nrm((DEPTH, 6 * D_MODEL), 0.02)
    norm1_g = 1.0 + nrm((DEPTH, D_MODEL), 0.02)
    norm2_g = 1.0 + nrm((DEPTH, D_MODEL), 0.02)
    mix_w_out = nrm((DEPTH, MIX_WIDTH, D_MODEL), MIX_WIDTH ** -0.5)
    mlp_w1 = nrm((DEPTH, D_MODEL, D_FF), D_MODEL ** -0.5)
    mlp_w2 = nrm((DEPTH, D_FF, D_MODEL), D_FF ** -0.5)
    ev_w_in = nrm((N_EVEN, D_MODEL, EV_IN), D_MODEL ** -0.5)
    lru_conv_w = nrm((N_EVEN, CONV_W, LRU_WIDTH), CONV_W ** -0.5)
    lru_conv_b = nrm((N_EVEN, LRU_WIDTH), 0.02)
    lru_wa = nrm((N_EVEN, 2, LRU_BLOCKS, LRU_BLOCK, LRU_BLOCK), LRU_BLOCK ** -0.5)
    lru_ba = nrm((N_EVEN, 2, LRU_WIDTH), 0.02)
    lru_wx = nrm((N_EVEN, 2, LRU_BLOCKS, LRU_BLOCK, LRU_BLOCK), LRU_BLOCK ** -0.5)
    lru_bx = nrm((N_EVEN, 2, LRU_WIDTH), 0.02)
    a_c = unif((N_EVEN, 2, LRU_WIDTH), 0.9, 0.999) ** (1.0 / LRU_C)
    lru_lambda = jnp.log(a_c) - jnp.log1p(-a_c)
    ret_base = jnp.log1p(-jnp.exp2(-5.0 - jnp.arange(RET_HEADS, dtype=F32)))
    ret_log_gamma = ret_base * jnp.exp(nrm((N_EVEN, 2, RET_HEADS), 0.1))
    od_w_in = nrm((N_ODD, D_MODEL, OD_IN), D_MODEL ** -0.5)
    hg_lb_logits = nrm((2, N_ODD, HG_HEADS * HG_DK), 0.1)
    gdn_conv_w = nrm((N_ODD, CONV_W, GDN_HEADS * (2 * GDN_DK + GDN_DV)), CONV_W ** -0.5)
    gdn_a_log = jnp.log(unif((N_ODD, 2, GDN_HEADS), 1.0, 16.0))
    dt = jnp.exp(unif((N_ODD, 2, GDN_HEADS), math.log(1e-3), math.log(1e-1)))
    gdn_dt_bias = dt + jnp.log(-jnp.expm1(-dt))
    final_g = 1.0 + nrm((D_MODEL,), 0.02)
    return {'x': x, 'c': c, 'ctx': ctx, 'c_ctx': c_ctx, 'ada_w': ada_w, 'ada_b': ada_b,
            'norm1_g': norm1_g, 'norm2_g': norm2_g, 'mix_w_out': mix_w_out, 'mlp_w1': mlp_w1,
            'mlp_w2': mlp_w2, 'ev_w_in': ev_w_in, 'lru_conv_w': lru_conv_w, 'lru_conv_b': lru_conv_b,
            'lru_wa': lru_wa, 'lru_ba': lru_ba, 'lru_wx': lru_wx, 'lru_bx': lru_bx,
            'lru_lambda': lru_lambda, 'ret_log_gamma': ret_log_gamma, 'od_w_in': od_w_in,
            'hg_lb_logits': hg_lb_logits, 'gdn_conv_w': gdn_conv_w, 'gdn_a_log': gdn_a_log,
            'gdn_dt_bias': gdn_dt_bias, 'final_g': final_g}


def reference(x, c, ctx, c_ctx, ada_w, ada_b, norm1_g, norm2_g, mix_w_out, mlp_w1, mlp_w2,
              ev_w_in, lru_conv_w, lru_conv_b, lru_wa, lru_ba, lru_wx, lru_bx, lru_lambda,
              ret_log_gamma, od_w_in, hg_lb_logits, gdn_conv_w, gdn_a_log, gdn_dt_bias, final_g):
    n_ctx = ctx.shape[1]
    rows = x.shape[1] // GRID_W
    cos, sin = _axial_rope(rows)
    sm = jax.nn.softmax(hg_lb_logits.astype(F32), axis=1)
    hg_lb = jnp.cumsum(sm, axis=1) - sm[:, :1]
    s_lat = jax.nn.silu(c)
    s_ctx = jax.nn.silu(c_ctx)[None, :]
    xl, xc = x, ctx
    for layer in range(DEPTH):
        mod_l = jnp.split((s_lat @ ada_w[layer] + ada_b[layer])[:, None, :], 6, axis=-1)
        mod_c = jnp.split((s_ctx @ ada_w[layer] + ada_b[layer])[:, None, :], 6, axis=-1)
        hl = _modulate(_rmsnorm(xl, norm1_g[layer]), mod_l[0], mod_l[1])
        hc = _modulate(_rmsnorm(xc, norm1_g[layer]), mod_c[0], mod_c[1])
        if layer % 2 == 0:
            e = layer // 2
            z = _even_mixer(hc, hl, ev_w_in[e], lru_conv_w[e], lru_conv_b[e], lru_wa[e], lru_ba[e],
                            lru_wx[e], lru_bx[e], lru_lambda[e], ret_log_gamma[e], cos, sin)
        else:
            o = layer // 2
            z = _odd_mixer(hc, hl, od_w_in[o], hg_lb[:, o], gdn_conv_w[o], gdn_a_log[o], gdn_dt_bias[o])
        xl = xl + mod_l[2] * (z[:, n_ctx:] @ mix_w_out[layer])
        hl2 = _modulate(_rmsnorm(xl, norm2_g[layer]), mod_l[3], mod_l[4])
        xl = xl + mod_l[5] * _sqrelu_mlp(hl2, mlp_w1[layer], mlp_w2[layer])
        if layer < DEPTH - 1:
            xc = xc + mod_c[2] * (z[:, :n_ctx] @ mix_w_out[layer])
            hc2 = _modulate(_rmsnorm(xc, norm2_g[layer]), mod_c[3], mod_c[4])
            xc = xc + mod_c[5] * _sqrelu_mlp(hc2, mlp_w1[layer], mlp_w2[layer])
    return _rmsnorm(xl, final_g)
```

```cpp
#include <hip/hip_runtime.h>
#include <hip/hip_cooperative_groups.h>
#include <cstdio>
namespace cg = cooperative_groups;

typedef unsigned short bf16_t;
using bf16x8 = __attribute__((ext_vector_type(8))) short;
using f32x4 = __attribute__((ext_vector_type(4))) float;

#define NTB 4352
#define TT 34816
#define DM 1024
#define DFF 4096
#define EV_IN 2560
#define OD_IN 4624
#define NTHREADS 512
#define LDS_BYTES 157696

#define OFF_XC   0ull
#define OFF_MOD  8388608ull
#define OFF_ROPE 9437184ull
#define OFF_W    10485760ull
#define OFF_BUFA 41943040ull
#define OFF_BUFB 113246208ull
#define OFF_BIG  184549376ull
#define WO_IN   0
#define WO_OUT  4849664
#define WO_W1   5898240
#define WO_W2   10092544

struct Params {
  const float* in[26];
  float* out;
  unsigned char* ws;
};

__device__ __forceinline__ float bf2f(bf16_t u) { return __uint_as_float(((unsigned)u) << 16); }
typedef __bf16 bf16x2_t __attribute__((ext_vector_type(2)));
__device__ __forceinline__ bf16_t f2bf(float f) { return __builtin_bit_cast(unsigned short, (__bf16)f); }
__device__ __forceinline__ unsigned pack2(float a, float b) { bf16x2_t v = {(__bf16)a, (__bf16)b}; return __builtin_bit_cast(unsigned, v); }
__device__ __forceinline__ float frcp_(float x) { return __builtin_amdgcn_rcpf(x); }
__device__ __forceinline__ float sigmoidf_(float x) { return frcp_(1.f + __expf(-x)); }
__device__ __forceinline__ float siluf_(float x) { return x * sigmoidf_(x); }
__device__ __forceinline__ float gelu_tanh(float x) {
  const float u = 0.7978845608028654f * (x + 0.044715f * x * x * x);
  const float t = 1.f - 2.f * frcp_(1.f + __expf(2.f * u));
  return 0.5f * x * (1.f + t);
}
__device__ __forceinline__ float softplusf_(float x) { return fmaxf(x, 0.f) + __logf(1.f + __expf(-fabsf(x))); }
template <int CTRL> __device__ __forceinline__ float dppf(float v) {
  return __int_as_float(__builtin_amdgcn_update_dpp(0, __float_as_int(v), CTRL, 0xF, 0xF, true));
}
__device__ __forceinline__ float quad_sum(float v) { v += dppf<0xB1>(v); v += dppf<0x4E>(v); return v; }
__device__ __forceinline__ float oct_sum(float v) { v = quad_sum(v); v += dppf<0x141>(v); return v; }
__device__ __forceinline__ float row16_sum(float v) { v = oct_sum(v); v += dppf<0x140>(v); return v; }
__device__ __forceinline__ float wave_sum(float v) {
  v = row16_sum(v);
  return __builtin_amdgcn_readlane(v, 0) + __builtin_amdgcn_readlane(v, 16) + __builtin_amdgcn_readlane(v, 32) + __builtin_amdgcn_readlane(v, 48);
}
__device__ __forceinline__ float wave_incl_scan(float v) {
  v += __int_as_float(__builtin_amdgcn_update_dpp(0, __float_as_int(v), 0x111, 0xF, 0xF, false));
  v += __int_as_float(__builtin_amdgcn_update_dpp(0, __float_as_int(v), 0x112, 0xF, 0xF, false));
  v += __int_as_float(__builtin_amdgcn_update_dpp(0, __float_as_int(v), 0x114, 0xF, 0xF, false));
  v += __int_as_float(__builtin_amdgcn_update_dpp(0, __float_as_int(v), 0x118, 0xF, 0xF, false));
  v += __int_as_float(__builtin_amdgcn_update_dpp(0, __float_as_int(v), 0x142, 0xA, 0xF, false));
  v += __int_as_float(__builtin_amdgcn_update_dpp(0, __float_as_int(v), 0x143, 0xC, 0xF, false));
  return v;
}
__device__ __forceinline__ int otid() { int t = threadIdx.x; asm volatile("" : "+v"(t)); return t; }
__device__ __forceinline__ float* xrow(const Params& p, int g) {
  int b = g / NTB, n = g - b * NTB;
  return n < 256 ? ((float*)(p.ws + OFF_XC) + (size_t)(b * 256 + n) * DM) : (p.out + (size_t)(b * 4096 + (n - 256)) * DM);
}
__device__ __forceinline__ const float* xrow_src(const Params& p, int g, bool first) {
  int b = g / NTB, n = g - b * NTB;
  if (first) return n < 256 ? (p.in[2] + (size_t)(b * 256 + n) * DM) : (p.in[0] + (size_t)(b * 4096 + (n - 256)) * DM);
  return n < 256 ? ((const float*)(p.ws + OFF_XC) + (size_t)(b * 256 + n) * DM) : (p.out + (size_t)(b * 4096 + (n - 256)) * DM);
}
__device__ __forceinline__ int scan2nat(int pos, int dir) { return dir ? (pos < 256 ? 255 - pos : 4607 - pos) : pos; }

__device__ __forceinline__ void phase0(const Params& p, char* lds) {
  const int tid = threadIdx.x, lane = tid & 63, wave = tid >> 6;
  float* sv = (float*)lds;
  float* red = (float*)(lds + 36864);
  const float* c = p.in[1];
  const float* cctx = p.in[3];
  for (int i = tid; i < 9 * 1024; i += NTHREADS) {
    float v = (i < 8192) ? c[i] : cctx[i - 8192];
    sv[i] = siluf_(v);
  }
  __syncthreads();
  float* mod = (float*)(p.ws + OFF_MOD);
  for (int it = blockIdx.x; it < 4 * 96; it += gridDim.x) {
    int l = it / 96, cg_ = it % 96;
    int col = cg_ * 64 + lane;
    const float* W = p.in[4] + (size_t)l * 1024 * 6144 + col;
    float acc[9];
#pragma unroll
    for (int r = 0; r < 9; ++r) acc[r] = 0.f;
#pragma unroll 8
    for (int k = wave * 128; k < wave * 128 + 128; ++k) {
      float w = W[(size_t)k * 6144];
#pragma unroll
      for (int r = 0; r < 9; ++r) acc[r] += sv[r * 1024 + k] * w;
    }
#pragma unroll
    for (int r = 0; r < 9; ++r) red[(wave * 9 + r) * 64 + lane] = acc[r];
    __syncthreads();
    for (int i = tid; i < 9 * 64; i += NTHREADS) {
      int r = i / 64, cc = i % 64;
      float s = 0.f;
#pragma unroll
      for (int w = 0; w < 8; ++w) s += red[(w * 9 + r) * 64 + cc];
      int colo = cg_ * 64 + cc;
      mod[((size_t)l * 9 + r) * 6144 + colo] = s + p.in[5][l * 6144 + colo];
    }
    __syncthreads();
  }
  const size_t gt = (size_t)blockIdx.x * NTHREADS + tid, gs = (size_t)gridDim.x * NTHREADS;
  float* ct = (float*)(p.ws + OFF_ROPE); float* st = ct + 4096 * 32;
  for (size_t i = gt; i < 4096 * 32; i += gs) {
    int t = (int)(i >> 5), pp = (int)(i & 31);
    int f = pp & 15;
    float inv = powf(10000.f, -(float)f / 16.f);
    float pos = (pp < 16) ? (float)(t >> 6) : (float)(t & 63);
    float ang = pos * inv;
    ct[i] = cosf(ang); st[i] = sinf(ang);
  }
}

__device__ __forceinline__ void norm_phase(const Params& p, int layer, int which) {
  const int tid = otid(), lane = tid & 63, wave = tid >> 6;
  const float* g = (which ? p.in[7] : p.in[6]) + layer * DM;
  const float* mod = (const float*)(p.ws + OFF_MOD) + (size_t)layer * 9 * 6144;
  bf16_t* dst = (bf16_t*)(p.ws + OFF_BUFA);
  for (int row = blockIdx.x * 8 + wave; row < TT; row += gridDim.x * 8) {
    int b = row / NTB, n = row - b * NTB;
    int r = n < 256 ? 8 : b;
    const float* x = xrow_src(p, row, layer == 0 && which == 0);
    const float* sh = mod + (size_t)r * 6144 + (which ? 3 : 0) * 1024;
    const float* sc = sh + 1024;
    float4 v[4]; float ss = 0.f;
#pragma unroll
    for (int i = 0; i < 4; ++i) { v[i] = *(const float4*)(x + i * 256 + lane * 4); ss += v[i].x * v[i].x + v[i].y * v[i].y + v[i].z * v[i].z + v[i].w * v[i].w; }
    ss = wave_sum(ss);
    float rstd = rsqrtf(ss * (1.f / 1024.f) + 1e-6f);
#pragma unroll
    for (int i = 0; i < 4; ++i) {
      int cidx = i * 256 + lane * 4;
      float4 gg = *(const float4*)(g + cidx), s1 = *(const float4*)(sc + cidx), s0 = *(const float4*)(sh + cidx);
      float a0 = v[i].x * rstd * gg.x * (1.f + s1.x) + s0.x;
      float a1 = v[i].y * rstd * gg.y * (1.f + s1.y) + s0.y;
      float a2 = v[i].z * rstd * gg.z * (1.f + s1.z) + s0.z;
      float a3 = v[i].w * rstd * gg.w * (1.f + s1.w) + s0.w;
      uint2 o; o.x = pack2(a0, a1); o.y = pack2(a2, a3);
      *(uint2*)(dst + (size_t)row * DM + cidx) = o;
    }
  }
}

__device__ __forceinline__ void final_norm(const Params& p) {
  const int tid = otid(), lane = tid & 63, wave = tid >> 6;
  const float* g = p.in[25];
  for (int row = blockIdx.x * 8 + wave; row < 8 * 4096; row += gridDim.x * 8) {
    float* x = p.out + (size_t)row * DM;
    float4 v[4]; float ss = 0.f;
#pragma unroll
    for (int i = 0; i < 4; ++i) { v[i] = *(const float4*)(x + i * 256 + lane * 4); ss += v[i].x * v[i].x + v[i].y * v[i].y + v[i].z * v[i].z + v[i].w * v[i].w; }
    ss = wave_sum(ss);
    float rstd = rsqrtf(ss * (1.f / 1024.f) + 1e-6f);
#pragma unroll
    for (int i = 0; i < 4; ++i) {
      int cidx = i * 256 + lane * 4;
      float4 gg = *(const float4*)(g + cidx);
      float4 o; o.x = v[i].x * rstd * gg.x; o.y = v[i].y * rstd * gg.y; o.z = v[i].z * rstd * gg.z; o.w = v[i].w * rstd * gg.w;
      *(float4*)(x + cidx) = o;
    }
  }
}

__device__ __forceinline__ void convert_weights(const Params& p, int layer, char* lds) {
  const int tid = otid();
  bf16_t* Tl = (bf16_t*)lds;
  bf16_t* wbase = (bf16_t*)(p.ws + OFF_W);
  const int odd = layer & 1;
  const float* srcs[4]; int Ks[4], Ns[4]; bf16_t* dsts[4]; int cnt[4];
  srcs[0] = odd ? p.in[20] + (size_t)(layer >> 1) * 1024 * OD_IN : p.in[11] + (size_t)(layer >> 1) * 1024 * EV_IN;
  Ks[0] = 1024; Ns[0] = odd ? OD_IN : EV_IN; dsts[0] = wbase + WO_IN;
  srcs[1] = p.in[8] + (size_t)layer * 1024 * 1024; Ks[1] = 1024; Ns[1] = 1024; dsts[1] = wbase + WO_OUT;
  srcs[2] = p.in[9] + (size_t)layer * 1024 * 4096; Ks[2] = 1024; Ns[2] = 4096; dsts[2] = wbase + WO_W1;
  srcs[3] = p.in[10] + (size_t)layer * 4096 * 1024; Ks[3] = 4096; Ns[3] = 1024; dsts[3] = wbase + WO_W2;
  int total = 0;
#pragma unroll
  for (int i = 0; i < 4; ++i) { cnt[i] = (Ks[i] / 64) * ((Ns[i] + 63) / 64); total += cnt[i]; }
  for (int it = blockIdx.x; it < total; it += gridDim.x) {
    int r = it, mi = 0;
    if (r >= cnt[0]) { r -= cnt[0]; mi = 1; if (r >= cnt[1]) { r -= cnt[1]; mi = 2; if (r >= cnt[2]) { r -= cnt[2]; mi = 3; } } }
    const float* W = mi == 0 ? srcs[0] : mi == 1 ? srcs[1] : mi == 2 ? srcs[2] : srcs[3];
    const int K = mi == 3 ? 4096 : 1024;
    const int N = mi == 0 ? Ns[0] : mi == 1 ? 1024 : mi == 2 ? 4096 : 1024;
    bf16_t* D = mi == 0 ? dsts[0] : mi == 1 ? dsts[1] : mi == 2 ? dsts[2] : dsts[3];
    const int ntn = (N + 63) / 64;
    const int kt = r / ntn, nt = r % ntn;
    const int k0 = kt * 64, n0 = nt * 64;
    {
      const int rr = tid >> 4, c4 = (tid & 15) * 4;
#pragma unroll
      for (int ps = 0; ps < 2; ++ps) {
        int k = k0 + rr + 32 * ps, n = n0 + c4;
        float4 v = make_float4(0.f, 0.f, 0.f, 0.f);
        if (n < N) v = *(const float4*)(W + (size_t)k * N + n);
        Tl[(c4 + 0) * 72 + rr + 32 * ps] = f2bf(v.x);
        Tl[(c4 + 1) * 72 + rr + 32 * ps] = f2bf(v.y);
        Tl[(c4 + 2) * 72 + rr + 32 * ps] = f2bf(v.z);
        Tl[(c4 + 3) * 72 + rr + 32 * ps] = f2bf(v.w);
      }
    }
    __syncthreads();
    {
      const int nr = tid >> 3, kc = tid & 7;
      if (n0 + nr < N) *(uint4*)(D + (size_t)(n0 + nr) * K + k0 + kc * 8) = *(const uint4*)(Tl + nr * 72 + kc * 8);
    }
    __syncthreads();
  }
}

template <int KS> __device__ __forceinline__ int lds_byte(int r, int c) {
  int st = (r >> 4) * KS + (c >> 5), ob = (r & 15) * 64 + (c & 31) * 2;
  return st * 1024 + (ob ^ (((ob >> 9) & 1) << 5));
}
template <int KS> __device__ __forceinline__ void stage_rc(int b, int& R, int& C) {
  int st = b >> 10, sb = b & 1023, swz = sb ^ (((sb >> 9) & 1) << 5);
  R = (st / KS) * 16 + swz / 64;
  C = (st % KS) * 32 + (swz % 64) / 2;
}
#define WAIT_V0() asm volatile("s_waitcnt vmcnt(0)" ::: "memory")

template <int EPI>
__device__ __forceinline__ void gemm_phase(const Params& p, const bf16_t* __restrict__ A, int lda_unused, const bf16_t* __restrict__ Bt, int N, int K,
                           bf16_t* outb, int ldo, const float* modv, char* lds, bool first = false) {
  constexpr int KS = 2, BK = 64, TA_B = 272 * BK * 2, TB_B = 256 * BK * 2, STAGE_B = TA_B + TB_B, NPASS = 9;
  const int tid = otid(), lane = tid & 63, wid = __builtin_amdgcn_readfirstlane(tid >> 6);
  const int fr = lane & 15, fq = lane >> 4;
  const int wr = wid >> 2, wc = wid & 3, rbase = wr * 144;
  const int nM = TT / 272, nN = (N + 255) / 256, nwg = nM * nN;
  const int nt = K / BK;
  int sR[NPASS], sC[NPASS];
#pragma unroll
  for (int i = 0; i < NPASS; ++i) {
    const int s = i * 8 + wid;
    const int sl = s < 34 ? s : s - 34;
    stage_rc<KS>(sl * 1024 + lane * 16, sR[i], sC[i]);
  }
  int so[NPASS];
  const bf16_t* Ab = A;
  int nbrow = 0, nbcol = 0;
#define TILE_COORDS(w) do { int wgid = (w); \
      { int q = nwg / 8, r = nwg % 8, xcd = wgid % 8, off = wgid / 8; \
        wgid = (xcd < r ? xcd * (q + 1) : r * (q + 1) + (xcd - r) * q) + off; } \
      const int nig = 4 * nN, gid = wgid / nig, fm = gid * 4, gsz = min(nM - fm, 4); \
      nbrow = (fm + ((wgid % nig) % gsz)) * 272; nbcol = ((wgid % nig) / gsz) * 256; \
      Ab = A + (size_t)nbrow * K; \
      _Pragma("unroll") for (int i = 0; i < NPASS; ++i) { const int s = i * 8 + wid; \
        if (s < 34) so[i] = (sR[i] * K + sC[i]) * 2; \
        else { int br = nbcol + sR[i]; if (br > N - 1) br = N - 1; so[i] = (br * K + sC[i]) * 2; } } } while (0)
#define GLDS_PART(buf, kt, i_lo, i_hi) do { const char* ga_ = (const char*)(Ab + (kt) * BK); const char* gb_ = (const char*)(Bt + (kt) * BK); \
    _Pragma("unroll") for (int i = (i_lo); i < (i_hi); ++i) { const int s = i * 8 + wid; \
      if (s < 66) __builtin_amdgcn_global_load_lds((const unsigned*)((s < 34 ? ga_ : gb_) + (unsigned)so[i]), (unsigned*)(lds + (buf) * STAGE_B + s * 1024), 16, 0, 0); } } while (0)
#define GLDS_STAGE(buf, kt) GLDS_PART(buf, kt, 0, NPASS)
  int w0 = blockIdx.x;
  if (w0 < nwg) { TILE_COORDS(w0); GLDS_STAGE(0, 0); }
  while (w0 < nwg) {
    const int brow = nbrow, bcol = nbcol;
    f32x4 acc[9][4];
#pragma unroll
    for (int m = 0; m < 9; ++m)
#pragma unroll
      for (int n = 0; n < 4; ++n) acc[m][n] = (f32x4){0.f, 0.f, 0.f, 0.f};
    WAIT_V0(); __syncthreads();
#pragma unroll 1
    for (int t = 0; t < nt; ++t) {
      const int cur = t & 1;
      const int tn = (t + 1 < nt) ? t + 1 : t;
      const char* sa = lds + cur * STAGE_B; const char* sb = sa + TA_B;
#pragma unroll
      for (int ks = 0; ks < KS; ++ks) {
        bf16x8 Bf[4], a0, a1;
#pragma unroll
        for (int n = 0; n < 4; ++n) Bf[n] = *(const bf16x8*)(sb + lds_byte<KS>(wc * 64 + n * 16 + fr, ks * 32 + fq * 8));
        a0 = *(const bf16x8*)(sa + lds_byte<KS>(rbase + fr, ks * 32 + fq * 8));
#pragma unroll
        for (int m = 0; m < 8; ++m) {
          if (m < 7 || wr == 0) a1 = *(const bf16x8*)(sa + lds_byte<KS>(rbase + (m + 1) * 16 + fr, ks * 32 + fq * 8));
          if (ks == 0) { if (m < 5) GLDS_PART(cur ^ 1, tn, m, m + 1); } else { if (m < 4) GLDS_PART(cur ^ 1, tn, 5 + m, 6 + m); }
          __builtin_amdgcn_s_setprio(1);
#pragma unroll
          for (int n = 0; n < 4; ++n) acc[m][n] = __builtin_amdgcn_mfma_f32_16x16x32_bf16(Bf[n], a0, acc[m][n], 0, 0, 0);
          __builtin_amdgcn_s_setprio(0);
          a0 = a1;
        }
        if (wr == 0) {
#pragma unroll
          for (int n = 0; n < 4; ++n) acc[8][n] = __builtin_amdgcn_mfma_f32_16x16x32_bf16(Bf[n], a0, acc[8][n], 0, 0, 0);
        }
      }
      WAIT_V0(); __syncthreads();
    }
    w0 += gridDim.x;
    if (w0 < nwg) { TILE_COORDS(w0); GLDS_STAGE(0, 0); }
    char* est = lds + STAGE_B + wid * 6912;
    if (EPI == 0 || EPI == 1) {
#pragma unroll
      for (int pi = 0; pi < 3; ++pi) {
#pragma unroll
        for (int mm = 0; mm < 3; ++mm) {
          const int m = pi * 3 + mm;
          if (m < 8 || wr == 0) {
#pragma unroll
            for (int n = 0; n < 4; ++n) {
              f32x4 v = acc[m][n];
              if (EPI == 1) {
#pragma unroll
                for (int j = 0; j < 4; ++j) { const float a = fmaxf(v[j], 0.f); v[j] = a * a; }
              }
              uint2 o; o.x = pack2(v[0], v[1]); o.y = pack2(v[2], v[3]);
              *(uint2*)(est + (mm * 16 + fr) * 144 + (n * 16 + fq * 4) * 2) = o;
            }
          }
        }
        asm volatile("" ::: "memory");
        const int nrows = (wr == 0 || pi < 2) ? 48 : 32;
#pragma unroll
        for (int q = 0; q < 6; ++q) {
          const int idx = q * 64 + lane, rl = idx >> 3, ch = idx & 7;
          const uint4 val = *(const uint4*)(est + rl * 144 + ch * 16);
          const int row = brow + rbase + pi * 48 + rl, col = bcol + wc * 64 + ch * 8;
          if (rl < nrows && col < N) *(uint4*)(outb + (size_t)row * ldo + col) = val;
        }
        asm volatile("" ::: "memory");
      }
    } else {
      const int ch = lane & 15, rq4 = lane >> 4;
      const int col = bcol + wc * 64 + ch * 4;
      const int bidx0 = brow / NTB;
      const float4 md_lat = *(const float4*)(modv + (size_t)bidx0 * 6144 + col);
      float4 xc[4], xn[4];
#pragma unroll
      for (int q = 0; q < 4; ++q) xc[q] = *(const float4*)(xrow_src(p, brow + rbase + q * 4 + rq4, first) + col);
#pragma unroll
      for (int m = 0; m < 9; ++m) {
        if (m < 8 || wr == 0) {
#pragma unroll
          for (int n = 0; n < 4; ++n) *(f32x4*)(est + fr * 272 + (n * 16 + fq * 4) * 4) = acc[m][n];
          if (m < 7 || (m == 7 && wr == 0)) {
#pragma unroll
            for (int q = 0; q < 4; ++q) xn[q] = *(const float4*)(xrow_src(p, brow + rbase + (m + 1) * 16 + q * 4 + rq4, first) + col);
          }
          asm volatile("" ::: "memory");
#pragma unroll
          for (int q = 0; q < 4; ++q) {
            const int rl = q * 4 + rq4;
            const float4 v = *(const float4*)(est + rl * 272 + ch * 16);
            const int row = brow + rbase + m * 16 + rl;
            const bool isctx = (row - bidx0 * NTB) < 256;
            float4 md = md_lat;
            if (isctx) md = *(const float4*)(modv + (size_t)8 * 6144 + col);
            float4 cur = xc[q];
            cur.x += md.x * v.x; cur.y += md.y * v.y; cur.z += md.z * v.z; cur.w += md.w * v.w;
            *(float4*)(xrow(p, row) + col) = cur;
          }
#pragma unroll
          for (int q = 0; q < 4; ++q) xc[q] = xn[q];
          asm volatile("" ::: "memory");
        }
      }
    }
  }
}

#undef GLDS_STAGE
#undef GLDS_PART
#undef TILE_COORDS

__device__ void chain_idle() {
  for (int pos = 0; pos < NTB; ++pos) { __syncthreads(); __syncthreads(); }
}

__device__ void chain_ret(const Params& p, int layer, int item, float* wl) {
  const int lane = otid() & 63;
  const int b = item >> 4, h = (item >> 2) & 3, dir = (item >> 1) & 1, vs = item & 1;
  const int e = layer >> 1;
  const bf16_t* proj = (const bf16_t*)(p.ws + OFF_BIG);
  bf16_t* ob = (bf16_t*)(p.ws + (dir ? OFF_BUFA : OFF_BUFB));
  const float* ct = (const float*)(p.ws + OFF_ROPE); const float* st = ct + 4096 * 32;
  const float gam = expf(p.in[19][(e * 2 + dir) * 4 + h]);
  float s[64];
#pragma unroll
  for (int d = 0; d < 64; ++d) s[d] = 0.f;
  float2* qk = (float2*)wl;
  for (int pos = 0; pos < NTB; ++pos) {
    const int n = scan2nat(pos, dir);
    const size_t g = (size_t)b * NTB + n;
    const bf16_t* row = proj + g * EV_IN;
    float qv = bf2f(row[1024 + h * 64 + lane]);
    float kv = bf2f(row[1280 + h * 64 + lane]) * 0.125f;
    float vv = bf2f(row[1536 + h * 128 + vs * 64 + lane]);
    float qo = __shfl_xor(qv, 32), ko = __shfl_xor(kv, 32);
    if (n >= 256) {
      int t = n - 256, pp = lane & 31;
      float c = ct[t * 32 + pp], sn = st[t * 32 + pp];
      if (lane < 32) { qv = qv * c - qo * sn; kv = kv * c - ko * sn; }
      else { qv = qo * sn + qv * c; kv = ko * sn + kv * c; }
    }
    qk[lane] = make_float2(qv, kv);
    __syncthreads();
    float o = 0.f;
#pragma unroll
    for (int d = 0; d < 64; d += 2) {
      float4 t4 = *(const float4*)(qk + d);
      s[d] = gam * s[d] + t4.y * vv; o += t4.x * s[d];
      s[d + 1] = gam * s[d + 1] + t4.w * vv; o += t4.z * s[d + 1];
      if ((d & 7) == 6) asm volatile("" ::: "memory");
    }
    ob[g * DM + 512 + h * 128 + vs * 64 + lane] = f2bf(o);
    __syncthreads();
  }
}

__device__ void chain_lru(const Params& p, int layer, int item, float* wl) {
  const int lane = otid() & 63;
  const int part = item & 1, kb = (item >> 1) & 7, dir = (item >> 4) & 1, b = item >> 5;
  const int e = layer >> 1;
  const int dh = lane >> 5, jl = (lane & 31) + 32 * part;
  const int chu = kb * 64 + lane;
  const int cho = kb * 64 + jl;
  const bf16_t* proj = (const bf16_t*)(p.ws + OFF_BIG);
  bf16_t* ob = (bf16_t*)(p.ws + (dir ? OFF_BUFA : OFF_BUFB));
  float cw[4];
#pragma unroll
  for (int t = 0; t < 4; ++t) cw[t] = p.in[12][(e * 4 + t) * 512 + chu];
  const float cb = p.in[13][e * 512 + chu];
  float wa[32], wx[32];
  {
    const float* wap = p.in[14] + ((size_t)((e * 2 + dir) * 8 + kb) * 64 + 32 * dh) * 64 + jl;
    const float* wxp = p.in[16] + ((size_t)((e * 2 + dir) * 8 + kb) * 64 + 32 * dh) * 64 + jl;
#pragma unroll
    for (int i = 0; i < 32; ++i) { wa[i] = wap[i * 64]; wx[i] = wxp[i * 64]; }
  }
  const float ba = p.in[15][(e * 2 + dir) * 512 + cho], bx = p.in[17][(e * 2 + dir) * 512 + cho];
  const float lam = p.in[18][(e * 2 + dir) * 512 + cho];
  const float spc = -8.f * softplusf_(-lam);
  float hst = 0.f;
  const float* wlh = wl + 32 * dh;
  for (int pos = 0; pos < NTB; ++pos) {
    const int n = scan2nat(pos, dir);
    const size_t g = (size_t)b * NTB + n;
    const int lo = n < 256 ? 0 : 256, hi = n < 256 ? 256 : NTB;
    float u = cb;
#pragma unroll
    for (int t = 0; t < 4; ++t) {
      int nn = n + t - 2;
      if (nn >= lo && nn < hi) u += cw[t] * bf2f(proj[((size_t)b * NTB + nn) * EV_IN + chu]);
    }
    wl[lane] = u;
    __syncthreads();
    float rp = 0.f, ip = 0.f;
#pragma unroll
    for (int i = 0; i < 32; i += 4) {
      float4 u4 = *(const float4*)(wlh + i);
      rp += u4.x * wa[i] + u4.y * wa[i + 1] + u4.z * wa[i + 2] + u4.w * wa[i + 3];
      ip += u4.x * wx[i] + u4.y * wx[i + 1] + u4.z * wx[i + 2] + u4.w * wx[i + 3];
    }
    rp += __shfl_xor(rp, 32); ip += __shfl_xor(ip, 32);
    rp += ba; ip += bx;
    float uo = wl[jl];
    float r = sigmoidf_(rp), ig = sigmoidf_(ip);
    float la = spc * r;
    float a = expf(la);
    float bb = sqrtf(-expm1f(2.f * la)) * ig * uo;
    hst = a * hst + bb;
    if (dh == 0) ob[g * DM + cho] = f2bf(hst);
    __syncthreads();
  }
}

__device__ void chain_gla(const Params& p, int layer, int item, float* wl) {
  const int lane = otid() & 63;
  const int vs4 = item & 3, dir = (item >> 2) & 1, h = (item >> 3) & 3, b = item >> 5;
  const int o_ = layer >> 1;
  const int dh = lane >> 5, vl = lane & 31;
  const bf16_t* proj = (const bf16_t*)(p.ws + OFF_BIG);
  bf16_t* ob = (bf16_t*)(p.ws + (dir ? OFF_BUFA : OFF_BUFB));
  float lb[2];
#pragma unroll
  for (int j = 0; j < 2; ++j) {
    int d = h * 128 + lane + 64 * j;
    float l0 = p.in[21][(dir * 2 + 0) * 512 + d], l1 = p.in[21][(dir * 2 + 1) * 512 + d];
    lb[j] = o_ == 0 ? 0.f : 1.f / (1.f + expf(l0 - l1));
  }
  float s[64];
#pragma unroll
  for (int d = 0; d < 64; ++d) s[d] = 0.f;
  float4* st4 = (float4*)wl;
  const float4* st4h = st4 + 64 * dh;
  for (int pos = 0; pos < NTB; ++pos) {
    const int n = scan2nat(pos, dir);
    const size_t g = (size_t)b * NTB + n;
    const bf16_t* row = proj + g * OD_IN;
#pragma unroll
    for (int j = 0; j < 2; ++j) {
      int d = lane + 64 * j;
      float hq = bf2f(row[h * 128 + d]);
      float fp = bf2f(row[(dir ? 1024 : 512) + h * 128 + d]);
      float sg = sigmoidf_(fp);
      float f = lb[j] + (1.f - lb[j]) * sg;
      st4[d] = make_float4(f, 1.f - f, siluf_(hq), 0.f);
    }
    float vv = bf2f(row[1536 + h * 128 + vs4 * 32 + vl]);
    __syncthreads();
    float o = 0.f;
#pragma unroll
    for (int d = 0; d < 64; ++d) {
      float4 t4 = st4h[d];
      s[d] = t4.x * s[d] + t4.y * vv; o += t4.z * s[d];
      if ((d & 3) == 3) asm volatile("" ::: "memory");
    }
    o += __shfl_xor(o, 32);
    if (dh == 0) ob[g * DM + h * 128 + vs4 * 32 + vl] = f2bf(o);
    __syncthreads();
  }
}

__device__ void chain_gdn(const Params& p, int layer, int item, float* wl) {
  const int lane = otid() & 63;
  const int vs4 = item & 3, dir = (item >> 2) & 1, h = (item >> 3) & 3, b = item >> 5;
  const int o_ = layer >> 1;
  const int dh = lane >> 5, vl = lane & 31;
  const bf16_t* proj = (const bf16_t*)(p.ws + OFF_BIG);
  bf16_t* ob = (bf16_t*)(p.ws + (dir ? OFF_BUFA : OFF_BUFB));
  int cch[5], pcol[5];
  cch[0] = h * 128 + lane;        pcol[0] = 2560 + cch[0];
  cch[1] = h * 128 + lane + 64;   pcol[1] = 2560 + cch[1];
  cch[2] = 512 + h * 128 + lane;  pcol[2] = 2560 + cch[2];
  cch[3] = 512 + h * 128 + lane + 64; pcol[3] = 2560 + cch[3];
  cch[4] = 1024 + h * 128 + vs4 * 32 + vl; pcol[4] = 2560 + cch[4];
  float cw[5][4];
#pragma unroll
  for (int j = 0; j < 5; ++j)
#pragma unroll
    for (int t = 0; t < 4; ++t) cw[j][t] = p.in[22][((size_t)o_ * 4 + t) * 1536 + cch[j]];
  const float aexp = expf(p.in[23][(o_ * 2 + dir) * 4 + h]);
  const float dtb = p.in[24][(o_ * 2 + dir) * 4 + h];
  float s[64];
#pragma unroll
  for (int d = 0; d < 64; ++d) s[d] = 0.f;
  float2* qk = (float2*)wl;
  const float2* qkh = qk + 64 * dh;
  for (int pos = 0; pos < NTB; ++pos) {
    const int n = scan2nat(pos, dir);
    const size_t g = (size_t)b * NTB + n;
    const int lo = n < 256 ? 0 : 256, hi = n < 256 ? 256 : NTB;
    float cv[5];
#pragma unroll
    for (int j = 0; j < 5; ++j) cv[j] = 0.f;
#pragma unroll
    for (int t = 0; t < 4; ++t) {
      int nn = n + t - 2;
      if (nn >= lo && nn < hi) {
        const bf16_t* rr = proj + ((size_t)b * NTB + nn) * OD_IN;
#pragma unroll
        for (int j = 0; j < 5; ++j) cv[j] += cw[j][t] * bf2f(rr[pcol[j]]);
      }
    }
#pragma unroll
    for (int j = 0; j < 5; ++j) cv[j] = siluf_(cv[j]);
    float sq = wave_sum(cv[0] * cv[0] + cv[1] * cv[1]);
    float sk = wave_sum(cv[2] * cv[2] + cv[3] * cv[3]);
    float rq = rsqrtf(sq + 1e-6f) * 0.08838834764831845f, rk = rsqrtf(sk + 1e-6f);
    qk[lane] = make_float2(cv[0] * rq, cv[2] * rk);
    qk[lane + 64] = make_float2(cv[1] * rq, cv[3] * rk);
    const bf16_t* row = proj + g * OD_IN;
    float beta = sigmoidf_(bf2f(row[4608 + dir * 4 + h]));
    float gg = -aexp * softplusf_(bf2f(row[4616 + dir * 4 + h]) + dtb);
    float alpha = expf(gg);
    __syncthreads();
    float kS = 0.f;
#pragma unroll
    for (int d = 0; d < 64; d += 2) {
      float4 t4 = *(const float4*)(qkh + d);
      kS += t4.y * s[d] + t4.w * s[d + 1];
      if ((d & 7) == 6) asm volatile("" ::: "memory");
    }
    kS += __shfl_xor(kS, 32);
    float vn = beta * (cv[4] - alpha * kS);
    float o = 0.f;
#pragma unroll
    for (int d = 0; d < 64; d += 2) {
      float4 t4 = *(const float4*)(qkh + d);
      s[d] = alpha * s[d] + t4.y * vn; o += t4.x * s[d];
      s[d + 1] = alpha * s[d + 1] + t4.w * vn; o += t4.z * s[d + 1];
      if ((d & 7) == 6) asm volatile("" ::: "memory");
    }
    o += __shfl_xor(o, 32);
    if (dh == 0) ob[g * DM + 512 + h * 128 + vs4 * 32 + vl] = f2bf(o);
    __syncthreads();
  }
}

template <int TM, int TN, int K>
__device__ __forceinline__ void lds_mma(const bf16_t* A, int lda, const bf16_t* B, int ldb, int m0, int n0, f32x4 (&acc)[TM][TN], int lane) {
  const int l15 = lane & 15, quad = lane >> 4;
  const bf16_t* ap = A + (m0 + l15) * lda + quad * 8;
  const bf16_t* bp = B + (n0 + l15) * ldb + quad * 8;
#pragma unroll
  for (int k = 0; k < K; k += 32) {
    bf16x8 a[TM], b[TN];
#pragma unroll
    for (int i = 0; i < TM; ++i) a[i] = *(const bf16x8*)(ap + i * 16 * lda + k);
#pragma unroll
    for (int j = 0; j < TN; ++j) b[j] = *(const bf16x8*)(bp + j * 16 * ldb + k);
#pragma unroll
    for (int i = 0; i < TM; ++i)
#pragma unroll
      for (int j = 0; j < TN; ++j) acc[i][j] = __builtin_amdgcn_mfma_f32_16x16x32_bf16(a[i], b[j], acc[i][j], 0, 0, 0);
  }
}
__device__ __forceinline__ void unpack8(uint4 u, float* f) {
  f[0] = __uint_as_float(u.x << 16); f[1] = __uint_as_float(u.x & 0xffff0000u);
  f[2] = __uint_as_float(u.y << 16); f[3] = __uint_as_float(u.y & 0xffff0000u);
  f[4] = __uint_as_float(u.z << 16); f[5] = __uint_as_float(u.z & 0xffff0000u);
  f[6] = __uint_as_float(u.w << 16); f[7] = __uint_as_float(u.w & 0xffff0000u);
}
__device__ __forceinline__ uint4 pack8(const float* f) {
  uint4 u; u.x = pack2(f[0], f[1]); u.y = pack2(f[2], f[3]); u.z = pack2(f[4], f[5]); u.w = pack2(f[6], f[7]); return u;
}

__device__ __forceinline__ void cret(const Params& p, int layer, int item, char* lds) {
  const int tid = otid(), lane = tid & 63, wave = tid >> 6, l15 = lane & 15, quad = lane >> 4;
  const int b = item >> 4, h = (item >> 2) & 3, dir = (item >> 1) & 1, vs = item & 1;
  const int e = layer >> 1;
  const bf16_t* proj = (const bf16_t*)(p.ws + OFF_BIG);
  bf16_t* ob = (bf16_t*)(p.ws + (dir ? OFF_BUFA : OFF_BUFB));
  const float* ct = (const float*)(p.ws + OFF_ROPE); const float* st = ct + 4096 * 32;
  const float lg = p.in[19][(e * 2 + dir) * 4 + h];
  bf16_t* PQ = (bf16_t*)lds;
  bf16_t* Ks = PQ + 128 * 200;
  bf16_t* KT = Ks + 128 * 72;
  bf16_t* VB = KT + 64 * 136;
  bf16_t* V2T = VB + 64 * 200;
  const float cdec = __expf(lg * 128.f);
  f32x4 S[1][2];
  S[0][0] = (f32x4){0.f, 0.f, 0.f, 0.f}; S[0][1] = S[0][0];
  for (int i = tid; i < 64 * 64; i += NTHREADS) VB[(i >> 6) * 200 + 128 + (i & 63)] = 0;
  const int si = tid >> 2, sq = tid & 3;
  const float qd = __expf(lg * (float)(si + 1)), kd = __expf(lg * (float)(127 - si));
  uint4 rr_[6]; float4 rc_[4];
  int rn_ = 0;
#define RET_LOAD(cc) do { rn_ = scan2nat((cc) * 128 + si, dir); const bf16_t* row_ = proj + ((size_t)b * NTB + rn_) * EV_IN; \
    rr_[0] = *(const uint4*)(row_ + 1024 + h * 64 + 8 * sq); rr_[1] = *(const uint4*)(row_ + 1024 + h * 64 + 32 + 8 * sq); \
    rr_[2] = *(const uint4*)(row_ + 1280 + h * 64 + 8 * sq); rr_[3] = *(const uint4*)(row_ + 1280 + h * 64 + 32 + 8 * sq); \
    rr_[4] = *(const uint4*)(row_ + 1536 + h * 128 + vs * 64 + 16 * sq); rr_[5] = *(const uint4*)(row_ + 1536 + h * 128 + vs * 64 + 16 * sq + 8); \
    { const int tt_ = rn_ >= 256 ? rn_ - 256 : 0; const float* cp_ = ct + tt_ * 32 + 8 * sq; const float* sp_ = st + tt_ * 32 + 8 * sq; \
      rc_[0] = *(const float4*)cp_; rc_[1] = *(const float4*)(cp_ + 4); rc_[2] = *(const float4*)sp_; rc_[3] = *(const float4*)(sp_ + 4); } } while (0)
  RET_LOAD(0);
  for (int c = 0; c < 34; ++c) {
    {
      const int n = rn_;
      float q1[8], q2[8], k1[8], k2[8];
      unpack8(rr_[0], q1);
      unpack8(rr_[1], q2);
      unpack8(rr_[2], k1);
      unpack8(rr_[3], k2);
      float vv[16];
      unpack8(rr_[4], vv);
      unpack8(rr_[5], vv + 8);
      float cc[8], ss[8];
      *(float4*)cc = rc_[0]; *(float4*)(cc + 4) = rc_[1];
      *(float4*)ss = rc_[2]; *(float4*)(ss + 4) = rc_[3];
      if (c + 1 < 34) RET_LOAD(c + 1);
      if (n >= 256) {
#pragma unroll
        for (int j = 0; j < 8; ++j) {
          float a1 = q1[j] * cc[j] - q2[j] * ss[j], a2 = q1[j] * ss[j] + q2[j] * cc[j]; q1[j] = a1; q2[j] = a2;
          float b1 = k1[j] * cc[j] - k2[j] * ss[j], b2 = k1[j] * ss[j] + k2[j] * cc[j]; k1[j] = b1; k2[j] = b2;
        }
      }
#pragma unroll
      for (int j = 0; j < 8; ++j) { q1[j] *= qd; q2[j] *= qd; k1[j] *= 0.125f; k2[j] *= 0.125f; }
      *(uint4*)(PQ + si * 200 + 128 + 8 * sq) = pack8(q1);
      *(uint4*)(PQ + si * 200 + 160 + 8 * sq) = pack8(q2);
      *(uint4*)(Ks + si * 72 + 8 * sq) = pack8(k1);
      *(uint4*)(Ks + si * 72 + 32 + 8 * sq) = pack8(k2);
#pragma unroll
      for (int j = 0; j < 8; ++j) { KT[(8 * sq + j) * 136 + si] = f2bf(k1[j]); KT[(32 + 8 * sq + j) * 136 + si] = f2bf(k2[j]); }
#pragma unroll
      for (int j = 0; j < 16; ++j) { VB[(16 * sq + j) * 200 + si] = f2bf(vv[j]); V2T[(16 * sq + j) * 136 + si] = f2bf(vv[j] * kd); }
    }
    __syncthreads();
    {
      const int m0 = wave * 16;
#pragma unroll
      for (int nt = 0; nt < 8; ++nt) {
        f32x4 acc[1][1]; acc[0][0] = (f32x4){0.f, 0.f, 0.f, 0.f};
        if (nt <= wave) lds_mma<1, 1, 64>(PQ + 128, 200, Ks, 72, m0, nt * 16, acc, lane);
        const int j = nt * 16 + l15;
        const float sc = __expf(-lg * (float)(j + 1));
#pragma unroll
        for (int r = 0; r < 4; ++r) {
          const int i = m0 + quad * 4 + r;
          float v = (nt <= wave && i >= j) ? acc[0][0][r] * sc : 0.f;
          PQ[i * 200 + j] = f2bf(v);
        }
      }
    }
    __syncthreads();
    {
      const int m0 = wave * 16;
      f32x4 acc[1][4];
#pragma unroll
      for (int j = 0; j < 4; ++j) acc[0][j] = (f32x4){0.f, 0.f, 0.f, 0.f};
      lds_mma<1, 4, 192>(PQ, 200, VB, 200, m0, 0, acc, lane);
#pragma unroll
      for (int r = 0; r < 4; ++r) {
        const int i = m0 + quad * 4 + r;
        const int n = scan2nat(c * 128 + i, dir);
        bf16_t* orow = ob + ((size_t)b * NTB + n) * DM + 512 + h * 128 + vs * 64 + l15;
#pragma unroll
        for (int j = 0; j < 4; ++j) orow[j * 16] = f2bf(acc[0][j][r]);
      }
    }
    const int sm0 = (wave >> 1) * 16, sn0 = (wave & 1) * 32;
    {
      S[0][0] *= cdec; S[0][1] *= cdec;
      lds_mma<1, 2, 128>(KT, 136, V2T, 136, sm0, sn0, S, lane);
    }
    __syncthreads();
#pragma unroll
    for (int j = 0; j < 2; ++j) {
      const int v = sn0 + j * 16 + l15, d = sm0 + quad * 4;
      uint2 u; u.x = pack2(S[0][j][0], S[0][j][1]); u.y = pack2(S[0][j][2], S[0][j][3]);
      *(uint2*)(VB + v * 200 + 128 + d) = u;
    }
  }
  __syncthreads();
}

__device__ __forceinline__ void clru(const Params& p, int layer, int item, char* lds) {
  const int tid = otid(), lane = tid & 63, wave = tid >> 6, l15 = lane & 15, quad = lane >> 4;
  const int kb = item & 7, dir = (item >> 3) & 1, b = item >> 4;
  const int e = layer >> 1;
  const bf16_t* proj = (const bf16_t*)(p.ws + OFF_BIG);
  bf16_t* ob = (bf16_t*)(p.ws + (dir ? OFF_BUFA : OFF_BUFB));
  bf16_t* Wt = (bf16_t*)lds;
  bf16_t* Ub = Wt + 128 * 72;
  float* Uf = (float*)(Ub + 64 * 72);
  float* LA = Uf + 64 * 64;
  float* IG = LA + 64 * 64;
  {
    const float* wap = p.in[14] + ((size_t)((e * 2 + dir) * 8 + kb) * 64) * 64;
    const float* wxp = p.in[16] + ((size_t)((e * 2 + dir) * 8 + kb) * 64) * 64;
    for (int i = tid; i < 4096; i += NTHREADS) {
      int ii = i >> 6, jj = i & 63;
      Wt[jj * 72 + ii] = f2bf(wap[i]);
      Wt[(64 + jj) * 72 + ii] = f2bf(wxp[i]);
    }
  }
  const int si = tid >> 3, sp = tid & 7;
  float cw[4][8], cb[8];
#pragma unroll
  for (int j = 0; j < 8; ++j) {
    const int ch = kb * 64 + sp * 8 + j;
    cb[j] = p.in[13][e * 512 + ch];
#pragma unroll
    for (int t = 0; t < 4; ++t) cw[t][j] = p.in[12][(e * 4 + t) * 512 + ch];
  }
  float gb[4], gs[4];
#pragma unroll
  for (int j = 0; j < 4; ++j) {
    const int jj = ((wave & 1) * 4 + j) * 16 + l15;
    if (jj < 64) { const int ch = kb * 64 + jj; gb[j] = p.in[15][(e * 2 + dir) * 512 + ch]; gs[j] = -8.f * softplusf_(-p.in[18][(e * 2 + dir) * 512 + ch]); }
    else { const int ch = kb * 64 + jj - 64; gb[j] = p.in[17][(e * 2 + dir) * 512 + ch]; gs[j] = 0.f; }
  }
  float hst = 0.f;
  __syncthreads();
  uint4 rx[4];
#define LRU_LOAD(cc) do { const int n_ = scan2nat((cc) * 64 + si, dir); const int lo_ = n_ < 256 ? 0 : 256, hi_ = n_ < 256 ? 256 : NTB; \
    _Pragma("unroll") for (int t = 0; t < 4; ++t) { const int nn = n_ + t - 2; const bool ok = (nn >= lo_ && nn < hi_); \
      const uint4 v_ = *(const uint4*)(proj + ((size_t)b * NTB + (ok ? nn : n_)) * EV_IN + kb * 64 + sp * 8); \
      rx[t] = ok ? v_ : make_uint4(0u, 0u, 0u, 0u); } } while (0)
  LRU_LOAD(0);
  for (int c = 0; c < 68; ++c) {
    {
      float u[8];
#pragma unroll
      for (int j = 0; j < 8; ++j) u[j] = cb[j];
#pragma unroll
      for (int t = 0; t < 4; ++t) {
        float xv[8];
        unpack8(rx[t], xv);
#pragma unroll
        for (int j = 0; j < 8; ++j) u[j] += cw[t][j] * xv[j];
      }
      if (c + 1 < 68) LRU_LOAD(c + 1);
      *(float4*)(Uf + si * 64 + sp * 8) = *(float4*)u;
      *(float4*)(Uf + si * 64 + sp * 8 + 4) = *(float4*)(u + 4);
      *(uint4*)(Ub + si * 72 + sp * 8) = pack8(u);
    }
    __syncthreads();
    {
      const int m0 = (wave >> 1) * 16, n0 = (wave & 1) * 64;
      f32x4 acc[1][4];
#pragma unroll
      for (int j = 0; j < 4; ++j) acc[0][j] = (f32x4){0.f, 0.f, 0.f, 0.f};
      lds_mma<1, 4, 64>(Ub, 72, Wt, 72, m0, n0, acc, lane);
#pragma unroll
      for (int j = 0; j < 4; ++j) {
        const int jj = n0 + j * 16 + l15;
#pragma unroll
        for (int r = 0; r < 4; ++r) {
          const int i = m0 + quad * 4 + r;
          const float sg = sigmoidf_(acc[0][j][r] + gb[j]);
          if (jj < 64) LA[i * 64 + jj] = gs[j] * sg; else IG[i * 64 + jj - 64] = sg;
        }
      }
    }
    __syncthreads();
    for (int i = tid; i < 4096; i += NTHREADS) {
      const float la = LA[i];
      const float a = __expf(la);
      const float bb = __builtin_amdgcn_sqrtf(fmaxf(1.f - a * a, 0.f)) * IG[i] * Uf[i];
      LA[i] = a; IG[i] = bb;
    }
    __syncthreads();
    if (wave == 0) {
#pragma unroll
      for (int bq = 0; bq < 4; ++bq) {
        float av[16], bv[16];
#pragma unroll
        for (int i = 0; i < 16; ++i) { av[i] = LA[(bq * 16 + i) * 64 + lane]; bv[i] = IG[(bq * 16 + i) * 64 + lane]; }
#pragma unroll
        for (int i = 0; i < 16; ++i) { hst = av[i] * hst + bv[i]; Uf[(bq * 16 + i) * 64 + lane] = hst; }
      }
    }
    __syncthreads();
    {
      const int n = scan2nat(c * 64 + si, dir);
      float hv[8];
      *(float4*)hv = *(const float4*)(Uf + si * 64 + sp * 8);
      *(float4*)(hv + 4) = *(const float4*)(Uf + si * 64 + sp * 8 + 4);
      *(uint4*)(ob + ((size_t)b * NTB + n) * DM + kb * 64 + sp * 8) = pack8(hv);
    }
    __syncthreads();
  }
}

__device__ __forceinline__ void cgla(const Params& p, int layer, int item, char* lds) {
  const int tid = otid(), lane = tid & 63, wave = tid >> 6, l15 = lane & 15, quad = lane >> 4;
  const int b = item >> 4, h = (item >> 2) & 3, dir = (item >> 1) & 1, vs = item & 1;
  const int o_ = layer >> 1;
  const bf16_t* proj = (const bf16_t*)(p.ws + OFF_BIG);
  bf16_t* ob = (bf16_t*)(p.ws + (dir ? OFF_BUFA : OFF_BUFB));
  float* AF = (float*)lds;
  bf16_t* PQ = (bf16_t*)(lds + 32768);
  bf16_t* Qt = PQ + 64 * 200;
  bf16_t* Kt = Qt + 64 * 136;
  bf16_t* VB = Kt + 64 * 136;
  bf16_t* K3T = VB + 64 * 200;
  float* LB = (float*)(K3T + 128 * 72);
  if (tid < 128) {
    const int d = h * 128 + tid;
    float l0 = p.in[21][(dir * 2 + 0) * 512 + d], l1 = p.in[21][(dir * 2 + 1) * 512 + d];
    LB[tid] = o_ == 0 ? 0.f : 1.f / (1.f + __expf(l0 - l1));
  }
  for (int i = tid; i < 64 * 128; i += NTHREADS) VB[(i >> 7) * 200 + 64 + (i & 127)] = 0;
  f32x4 S[1][4];
#pragma unroll
  for (int j = 0; j < 4; ++j) S[0][j] = (f32x4){0.f, 0.f, 0.f, 0.f};
  const int si = tid >> 3, sp = tid & 7;
  __syncthreads();
  for (int c = 0; c < 68; ++c) {
    float qr[16], kr[16];
    const int n_s = scan2nat(c * 64 + si, dir);
    const bf16_t* row = proj + ((size_t)b * NTB + n_s) * OD_IN;
    {
      float fp[16];
      unpack8(*(const uint4*)(row + h * 128 + 16 * sp), qr);
      unpack8(*(const uint4*)(row + h * 128 + 16 * sp + 8), qr + 8);
      unpack8(*(const uint4*)(row + (dir ? 1024 : 512) + h * 128 + 16 * sp), fp);
      unpack8(*(const uint4*)(row + (dir ? 1024 : 512) + h * 128 + 16 * sp + 8), fp + 8);
#pragma unroll
      for (int j = 0; j < 16; ++j) {
        const float lb = LB[16 * sp + j];
        const float f = lb + (1.f - lb) * sigmoidf_(fp[j]);
        kr[j] = 1.f - f;
        qr[j] = siluf_(qr[j]);
        AF[si * 128 + 16 * sp + j] = __logf(f);
      }
      float vv[8];
      unpack8(*(const uint4*)(row + 1536 + h * 128 + vs * 64 + 8 * sp), vv);
#pragma unroll
      for (int j = 0; j < 8; ++j) VB[(8 * sp + j) * 200 + si] = f2bf(vv[j]);
    }
    __syncthreads();
    if (tid < 128) {
      float a = 0.f;
#pragma unroll 8
      for (int i = 0; i < 64; ++i) { a += AF[i * 128 + tid]; AF[i * 128 + tid] = a; }
    }
    __syncthreads();
    {
      float t1[16], t2[16], t3[16];
#pragma unroll
      for (int j = 0; j < 16; ++j) {
        const int d = 16 * sp + j;
        const float a = AF[si * 128 + d], rr = AF[31 * 128 + d], al = AF[63 * 128 + d];
        t1[j] = qr[j] * __expf(a - rr);
        t2[j] = kr[j] * __expf(rr - a);
        t3[j] = qr[j] * __expf(a);
        K3T[d * 72 + si] = f2bf(kr[j] * __expf(al - a));
      }
      *(uint4*)(Qt + si * 136 + 16 * sp) = pack8(t1); *(uint4*)(Qt + si * 136 + 16 * sp + 8) = pack8(t1 + 8);
      *(uint4*)(Kt + si * 136 + 16 * sp) = pack8(t2); *(uint4*)(Kt + si * 136 + 16 * sp + 8) = pack8(t2 + 8);
      *(uint4*)(PQ + si * 200 + 64 + 16 * sp) = pack8(t3); *(uint4*)(PQ + si * 200 + 64 + 16 * sp + 8) = pack8(t3 + 8);
    }
    __syncthreads();
    {
      const int m0 = (wave >> 1) * 16, n0 = (wave & 1) * 32;
      f32x4 acc[1][2]; acc[0][0] = (f32x4){0.f, 0.f, 0.f, 0.f}; acc[0][1] = acc[0][0];
      lds_mma<1, 2, 128>(Qt, 136, Kt, 136, m0, n0, acc, lane);
#pragma unroll
      for (int j = 0; j < 2; ++j)
#pragma unroll
        for (int r = 0; r < 4; ++r) {
          const int i = m0 + quad * 4 + r, jj = n0 + j * 16 + l15;
          PQ[i * 200 + jj] = f2bf(i >= jj ? acc[0][j][r] : 0.f);
        }
    }
    __syncthreads();
    {
      const int m0 = (wave >> 1) * 16, n0 = (wave & 1) * 32;
      f32x4 acc[1][2]; acc[0][0] = (f32x4){0.f, 0.f, 0.f, 0.f}; acc[0][1] = acc[0][0];
      lds_mma<1, 2, 192>(PQ, 200, VB, 200, m0, n0, acc, lane);
#pragma unroll
      for (int r = 0; r < 4; ++r) {
        const int i = m0 + quad * 4 + r;
        const int n = scan2nat(c * 64 + i, dir);
        bf16_t* orow = ob + ((size_t)b * NTB + n) * DM + h * 128 + vs * 64 + n0 + l15;
        orow[0] = f2bf(acc[0][0][r]); orow[16] = f2bf(acc[0][1][r]);
      }
    }
    {
      const int m0 = wave * 16;
#pragma unroll
      for (int r = 0; r < 4; ++r) {
        const float dec = __expf(AF[63 * 128 + m0 + quad * 4 + r]);
#pragma unroll
        for (int j = 0; j < 4; ++j) S[0][j][r] *= dec;
      }
      lds_mma<1, 4, 64>(K3T, 72, VB, 200, m0, 0, S, lane);
    }
    __syncthreads();
#pragma unroll
    for (int j = 0; j < 4; ++j) {
      const int v = j * 16 + l15, d = wave * 16 + quad * 4;
      uint2 u; u.x = pack2(S[0][j][0], S[0][j][1]); u.y = pack2(S[0][j][2], S[0][j][3]);
      *(uint2*)(VB + v * 200 + 64 + d) = u;
    }
  }
  __syncthreads();
}

#define OFF_GC   506527744ull
#define OFF_BETA 507641856ull
__device__ __forceinline__ void gdn_prep_phase(const Params& p, int layer, char* lds) {
  const int tid = otid(), lane = tid & 63, wave = tid >> 6, l15 = lane & 15, quad = lane >> 4;
  const int o_ = layer >> 1;
  const bf16_t* proj = (const bf16_t*)(p.ws + OFF_BIG);
  bf16_t* Ks = (bf16_t*)lds;
  float* KK = (float*)(Ks + 64 * 136);
  float* Mf = KK + 64 * 68;
  float* CWA = Mf + 2 * 64 * 68;
  float* sm = CWA + 2048;
  float* gcg = (float*)(p.ws + OFF_GC);
  float* btg = (float*)(p.ws + OFF_BETA);
  const int si = tid >> 3, sp = tid & 7;
  for (int i = tid; i < 2048; i += NTHREADS) {
    const int hh = i >> 9, t = (i >> 7) & 3, d = i & 127;
    CWA[i] = p.in[22][((size_t)o_ * 4 + t) * 1536 + 512 + hh * 128 + d];
  }
  uint4 pk[4][2]; float pgb = 0.f, pga = 0.f;
#define PREP_LOAD(it_) do { const int cn_ = (it_) % 68, h_ = ((it_) / 68) & 3, b_ = (it_) / 272; \
    const int n_ = cn_ * 64 + si; const int lo_ = n_ < 256 ? 0 : 256, hi_ = n_ < 256 ? 256 : NTB; \
    _Pragma("unroll") for (int t = 0; t < 4; ++t) { const int nn = n_ + t - 2; const bool ok = (nn >= lo_ && nn < hi_); \
      const bf16_t* rr = proj + ((size_t)b_ * NTB + (ok ? nn : n_)) * OD_IN + 3072 + h_ * 128 + 16 * sp; \
      const uint4 a_ = *(const uint4*)rr, c_ = *(const uint4*)(rr + 8); \
      pk[t][0] = ok ? a_ : make_uint4(0u, 0u, 0u, 0u); pk[t][1] = ok ? c_ : make_uint4(0u, 0u, 0u, 0u); } \
    if (wave < 2) { const int ng_ = wave ? (cn_ * 64 + 63 - lane) : (cn_ * 64 + lane); \
      const bf16_t* row_ = proj + ((size_t)b_ * NTB + ng_) * OD_IN; \
      pgb = bf2f(row_[4608 + wave * 4 + h_]); pga = bf2f(row_[4616 + wave * 4 + h_]); } } while (0)
  if ((int)blockIdx.x < 8 * 4 * 68) PREP_LOAD((int)blockIdx.x);
  __syncthreads();
  for (int item = blockIdx.x; item < 8 * 4 * 68; item += gridDim.x) {
    const int cn = item % 68, h = (item / 68) & 3, b = item / 272;
    const int n0 = cn * 64;
    {
      float ak[16];
#pragma unroll
      for (int j = 0; j < 16; ++j) ak[j] = 0.f;
#pragma unroll
      for (int t = 0; t < 4; ++t) {
        float x[16];
        unpack8(pk[t][0], x); unpack8(pk[t][1], x + 8);
#pragma unroll
        for (int j = 0; j < 16; ++j) ak[j] += CWA[(h * 4 + t) * 128 + 16 * sp + j] * x[j];
      }
      float sk = 0.f;
#pragma unroll
      for (int j = 0; j < 16; ++j) { ak[j] = siluf_(ak[j]); sk += ak[j] * ak[j]; }
      sk = oct_sum(sk);
      const float rk = rsqrtf(sk + 1e-6f);
#pragma unroll
      for (int j = 0; j < 16; ++j) ak[j] *= rk;
      *(uint4*)(Ks + si * 136 + 16 * sp) = pack8(ak); *(uint4*)(Ks + si * 136 + 16 * sp + 8) = pack8(ak + 8);
    }
    const float gbv = pgb, gav = pga;
    if (item + (int)gridDim.x < 8 * 4 * 68) PREP_LOAD(item + (int)gridDim.x);
    if (wave < 2) {
      const int dir = wave;
      const int n = dir ? (n0 + 63 - lane) : (n0 + lane);
      const float aexp = __expf(p.in[23][(o_ * 2 + dir) * 4 + h]);
      const float dtb = p.in[24][(o_ * 2 + dir) * 4 + h];
      const float beta = sigmoidf_(gbv);
      float v = wave_incl_scan(-aexp * softplusf_(gav + dtb));
      sm[(dir * 2 + 0) * 64 + lane] = beta;
      sm[(dir * 2 + 1) * 64 + lane] = v;
      const size_t gi = ((size_t)((b * 4 + h) * 2 + dir)) * NTB + n;
      gcg[gi] = v; btg[gi] = beta;
    }
    __syncthreads();
    {
      const int m0 = (wave >> 1) * 16, nn0 = (wave & 1) * 32;
      f32x4 acc[1][2]; acc[0][0] = (f32x4){0.f, 0.f, 0.f, 0.f}; acc[0][1] = acc[0][0];
      lds_mma<1, 2, 128>(Ks, 136, Ks, 136, m0, nn0, acc, lane);
#pragma unroll
      for (int j = 0; j < 2; ++j)
#pragma unroll
        for (int r = 0; r < 4; ++r) KK[(m0 + quad * 4 + r) * 68 + nn0 + j * 16 + l15] = acc[0][j][r];
    }
    __syncthreads();
    for (int idx = tid; idx < 2 * 4096; idx += NTHREADS) {
      const int dir = idx >> 12, is = (idx >> 6) & 63, js = idx & 63;
      const int in_ = dir ? 63 - is : is, jn = dir ? 63 - js : js;
      float val = 0.f;
      if (js < is) val = sm[(dir * 2) * 64 + is] * KK[in_ * 68 + jn] * __expf(sm[(dir * 2 + 1) * 64 + is] - sm[(dir * 2 + 1) * 64 + js]);
      Mf[(dir * 64 + is) * 68 + (js & 3) * 16 + (js >> 2)] = val;
    }
    __syncthreads();
    {
      const int dir = tid >> 8, col = (tid & 255) >> 2, q = tid & 3;
      const float* M = Mf + dir * 64 * 68 + q * 16;
      bf16_t* obp = (bf16_t*)(p.ws + (dir ? OFF_BUFA : OFF_BUFB)) + (size_t)b * NTB * DM + 512 + h * 128 + col;
      float xo[16], mc[16], mn[16];
#pragma unroll
      for (int m = 0; m < 16; ++m) { xo[m] = 0.f; mc[m] = 0.f; mn[m] = 0.f; }
#pragma unroll
      for (int i = 0; i < 64; ++i) {
        if (i < 63) {
#pragma unroll
          for (int m4 = 0; m4 <= (i >> 4); ++m4) *(float4*)(mn + 4 * m4) = *(const float4*)(M + (i + 1) * 68 + 4 * m4);
        }
        float part = 0.f;
        if (i > 0) {
#pragma unroll
          for (int m = 0; m <= ((i - 1) >> 2); ++m) part += mc[m] * xo[m];
        }
        part = quad_sum(part);
        const float xi = ((i == col) ? 1.f : 0.f) - part;
        if ((i & 3) == q) xo[i >> 2] = xi;
        if (q == 0) {
          const int n = dir ? (n0 + 63 - i) : (n0 + i);
          const bf16_t xb = f2bf(xi);
          obp[(size_t)n * DM] = xb; obp[(size_t)n * DM + 64] = xb;
        }
#pragma unroll
        for (int m = 0; m < 16; ++m) mc[m] = mn[m];
      }
    }
    __syncthreads();
  }
}

#undef PREP_LOAD
__device__ __forceinline__ void cgdn(const Params& p, int layer, int item, char* lds) {
  const int tid = otid(), lane = tid & 63, wave = tid >> 6, l15 = lane & 15, quad = lane >> 4;
  const int b = item >> 4, h = (item >> 2) & 3, dir = (item >> 1) & 1, vs = item & 1;
  const int o_ = layer >> 1;
  const bf16_t* proj = (const bf16_t*)(p.ws + OFF_BIG);
  bf16_t* ob = (bf16_t*)(p.ws + (dir ? OFF_BUFA : OFF_BUFB));
  const float* gcg = (const float*)(p.ws + OFF_GC) + ((size_t)((b * 4 + h) * 2 + dir)) * NTB;
  const float* btg = (const float*)(p.ws + OFF_BETA) + ((size_t)((b * 4 + h) * 2 + dir)) * NTB;
  bf16_t* Qs = (bf16_t*)lds;
  bf16_t* Ks = Qs + 64 * 136;
  bf16_t* KT = Ks + 64 * 136;
  bf16_t* Ks2 = KT + 128 * 72;
  bf16_t* Tm = Ks2 + 64 * 136;
  bf16_t* PQ = Tm + 64 * 72;
  bf16_t* VB = PQ + 64 * 200;
  bf16_t* V2T = VB + 64 * 200;
  bf16_t* RT = V2T + 64 * 72;
  float* CW = (float*)(RT + 64 * 72);
  float* gcs = CW + 4 * 320;
  float* e2 = gcs + 64;
  for (int i = tid; i < 4 * 320; i += NTHREADS) {
    const int t = i / 320, cc = i % 320;
    const int ch = cc < 128 ? (h * 128 + cc) : cc < 256 ? (512 + h * 128 + cc - 128) : (1024 + h * 128 + vs * 64 + cc - 256);
    CW[i] = p.in[22][((size_t)o_ * 4 + t) * 1536 + ch];
  }
  for (int i = tid; i < 64 * 128; i += NTHREADS) VB[(i >> 7) * 200 + 64 + (i & 127)] = 0;
  f32x4 S[1][4];
#pragma unroll
  for (int j = 0; j < 4; ++j) S[0][j] = (f32x4){0.f, 0.f, 0.f, 0.f};
  const int si = tid >> 3, sp = tid & 7;
  const int tp = tid >> 4, cg = tid & 15;
  const int m0 = (wave >> 1) * 16, n0 = (wave & 1) * 32;
  uint4 rq[5], rk[5], rtt; uint2 rv[5]; float rg0, rg1, rb0, rb1, rgl;
#define GDN_LOAD(cc) do { \
    const int na_ = scan2nat((cc) * 64 + 2 * tp, dir); \
    const int nlo_ = dir ? na_ - 1 : na_; \
    const int lo_ = nlo_ < 256 ? 0 : 256, hi_ = nlo_ < 256 ? 256 : NTB; \
    const int nb_ = dir ? na_ - 1 : na_ + 1; \
    rg0 = gcg[na_]; rg1 = gcg[nb_]; rb0 = btg[na_]; rb1 = btg[nb_]; rgl = gcg[scan2nat((cc) * 64 + 63, dir)]; \
    rtt = *(const uint4*)(ob + ((size_t)b * NTB + scan2nat((cc) * 64 + si, dir)) * DM + 512 + h * 128 + vs * 64 + 8 * sp); \
    _Pragma("unroll") for (int k = 0; k < 5; ++k) { \
      const int nn = nlo_ - 2 + k; \
      const bool ok = (nn >= lo_ && nn < hi_); \
      const bf16_t* rr = proj + ((size_t)b * NTB + (ok ? nn : nlo_)) * OD_IN; \
      const uint4 a_ = *(const uint4*)(rr + 2560 + h * 128 + 8 * cg); \
      const uint4 b_ = *(const uint4*)(rr + 3072 + h * 128 + 8 * cg); \
      const uint2 c_ = *(const uint2*)(rr + 3584 + h * 128 + vs * 64 + 4 * cg); \
      rq[k] = ok ? a_ : make_uint4(0u, 0u, 0u, 0u); rk[k] = ok ? b_ : make_uint4(0u, 0u, 0u, 0u); rv[k] = ok ? c_ : make_uint2(0u, 0u); } } while (0)
  GDN_LOAD(0);
  __syncthreads();
  for (int c = 0; c < 68; ++c) {
    float gl;
    {
      gl = rgl;
      const float gc0 = rg0, gc1 = rg1, bi0 = rb0, bi1 = rb1;
      *(uint4*)(Tm + si * 72 + 8 * sp) = rtt;
      const int i0 = 2 * tp, i1 = 2 * tp + 1;
      const float eg0 = __expf(gc0), eg1 = __expf(gc1), kb0 = bi0 * eg0, kb1 = bi1 * eg1;
      {
        float aL[8], aH[8];
#pragma unroll
        for (int j = 0; j < 8; ++j) { aL[j] = 0.f; aH[j] = 0.f; }
#pragma unroll
        for (int k = 0; k < 5; ++k) {
          float x[8]; unpack8(rq[k], x);
          if (k < 4) {
#pragma unroll
            for (int j = 0; j < 8; ++j) aL[j] += CW[k * 320 + 8 * cg + j] * x[j];
          }
          if (k > 0) {
#pragma unroll
            for (int j = 0; j < 8; ++j) aH[j] += CW[(k - 1) * 320 + 8 * cg + j] * x[j];
          }
        }
        float sL = 0.f, sH = 0.f;
#pragma unroll
        for (int j = 0; j < 8; ++j) { aL[j] = siluf_(aL[j]); aH[j] = siluf_(aH[j]); sL += aL[j] * aL[j]; sH += aH[j] * aH[j]; }
        sL = row16_sum(sL); sH = row16_sum(sH);
        const float rL = rsqrtf(sL + 1e-6f) * 0.08838834764831845f, rH = rsqrtf(sH + 1e-6f) * 0.08838834764831845f;
        float q0[8], q1[8];
#pragma unroll
        for (int j = 0; j < 8; ++j) { const float a_ = aL[j] * rL, b_ = aH[j] * rH; q0[j] = dir ? b_ : a_; q1[j] = dir ? a_ : b_; }
        *(uint4*)(Qs + i0 * 136 + 8 * cg) = pack8(q0); *(uint4*)(Qs + i1 * 136 + 8 * cg) = pack8(q1);
#pragma unroll
        for (int j = 0; j < 8; ++j) { q0[j] *= eg0; q1[j] *= eg1; }
        *(uint4*)(PQ + i0 * 200 + 64 + 8 * cg) = pack8(q0); *(uint4*)(PQ + i1 * 200 + 64 + 8 * cg) = pack8(q1);
      }
      asm volatile("" ::: "memory");
      {
        float aL[8], aH[8];
#pragma unroll
        for (int j = 0; j < 8; ++j) { aL[j] = 0.f; aH[j] = 0.f; }
#pragma unroll
        for (int k = 0; k < 5; ++k) {
          float x[8]; unpack8(rk[k], x);
          if (k < 4) {
#pragma unroll
            for (int j = 0; j < 8; ++j) aL[j] += CW[k * 320 + 128 + 8 * cg + j] * x[j];
          }
          if (k > 0) {
#pragma unroll
            for (int j = 0; j < 8; ++j) aH[j] += CW[(k - 1) * 320 + 128 + 8 * cg + j] * x[j];
          }
        }
        float sL = 0.f, sH = 0.f;
#pragma unroll
        for (int j = 0; j < 8; ++j) { aL[j] = siluf_(aL[j]); aH[j] = siluf_(aH[j]); sL += aL[j] * aL[j]; sH += aH[j] * aH[j]; }
        sL = row16_sum(sL); sH = row16_sum(sH);
        const float rL = rsqrtf(sL + 1e-6f), rH = rsqrtf(sH + 1e-6f);
        float k0[8], k1[8];
#pragma unroll
        for (int j = 0; j < 8; ++j) { const float a_ = aL[j] * rL, b_ = aH[j] * rH; k0[j] = dir ? b_ : a_; k1[j] = dir ? a_ : b_; }
        *(uint4*)(Ks + i0 * 136 + 8 * cg) = pack8(k0); *(uint4*)(Ks + i1 * 136 + 8 * cg) = pack8(k1);
#pragma unroll
        for (int j = 0; j < 8; ++j) *(unsigned*)(KT + (8 * cg + j) * 72 + i0) = pack2(k0[j], k1[j]);
#pragma unroll
        for (int j = 0; j < 8; ++j) { k0[j] *= kb0; k1[j] *= kb1; }
        *(uint4*)(Ks2 + i0 * 136 + 8 * cg) = pack8(k0); *(uint4*)(Ks2 + i1 * 136 + 8 * cg) = pack8(k1);
      }
      asm volatile("" ::: "memory");
      {
        float aL[4], aH[4];
#pragma unroll
        for (int j = 0; j < 4; ++j) { aL[j] = 0.f; aH[j] = 0.f; }
#pragma unroll
        for (int k = 0; k < 5; ++k) {
          float x[4];
          x[0] = __uint_as_float(rv[k].x << 16); x[1] = __uint_as_float(rv[k].x & 0xffff0000u);
          x[2] = __uint_as_float(rv[k].y << 16); x[3] = __uint_as_float(rv[k].y & 0xffff0000u);
          if (k < 4) {
#pragma unroll
            for (int j = 0; j < 4; ++j) aL[j] += CW[k * 320 + 256 + 4 * cg + j] * x[j];
          }
          if (k > 0) {
#pragma unroll
            for (int j = 0; j < 4; ++j) aH[j] += CW[(k - 1) * 320 + 256 + 4 * cg + j] * x[j];
          }
        }
#pragma unroll
        for (int j = 0; j < 4; ++j) {
          const float a_ = siluf_(aL[j]), b_ = siluf_(aH[j]);
          *(unsigned*)(VB + (4 * cg + j) * 200 + i0) = pack2((dir ? b_ : a_) * bi0, (dir ? a_ : b_) * bi1);
        }
      }
      asm volatile("" ::: "memory");
      if (c + 1 < 68) GDN_LOAD(c + 1);
      if (cg == 0) { gcs[i0] = gc0; gcs[i1] = gc1; e2[i0] = __expf(gl - gc0); e2[i1] = __expf(gl - gc1); }
    }
    __syncthreads();
    {
      f32x4 a2[1][2];
      a2[0][0] = (f32x4){0.f, 0.f, 0.f, 0.f}; a2[0][1] = a2[0][0];
      lds_mma<1, 2, 128>(Qs, 136, Ks, 136, m0, n0, a2, lane);
#pragma unroll
      for (int j = 0; j < 2; ++j)
#pragma unroll
        for (int r = 0; r < 4; ++r) {
          const int i = m0 + quad * 4 + r, jj = n0 + j * 16 + l15;
          PQ[i * 200 + jj] = f2bf((i >= jj) ? a2[0][j][r] * __expf(gcs[i] - gcs[jj]) : 0.f);
        }
      f32x4 pa[1][2];
      pa[0][0] = (f32x4){0.f, 0.f, 0.f, 0.f}; pa[0][1] = pa[0][0];
      lds_mma<1, 2, 128>(Ks2, 136, VB + 64, 200, m0, n0, pa, lane);
#pragma unroll
      for (int j = 0; j < 2; ++j) {
        const int v = n0 + j * 16 + l15, j0 = m0 + quad * 4;
        const uint2 vb = *(const uint2*)(VB + v * 200 + j0);
        const float v0 = __uint_as_float(vb.x << 16), v1 = __uint_as_float(vb.x & 0xffff0000u);
        const float v2 = __uint_as_float(vb.y << 16), v3 = __uint_as_float(vb.y & 0xffff0000u);
        uint2 o; o.x = pack2(v0 - pa[0][j][0], v1 - pa[0][j][1]); o.y = pack2(v2 - pa[0][j][2], v3 - pa[0][j][3]);
        *(uint2*)(RT + v * 72 + j0) = o;
      }
    }
    __syncthreads();
    {
      f32x4 acc[1][2]; acc[0][0] = (f32x4){0.f, 0.f, 0.f, 0.f}; acc[0][1] = acc[0][0];
      lds_mma<1, 2, 64>(Tm, 72, RT, 72, m0, n0, acc, lane);
#pragma unroll
      for (int j = 0; j < 2; ++j) {
        const int v = n0 + j * 16 + l15, i0 = m0 + quad * 4;
        uint2 o; o.x = pack2(acc[0][j][0], acc[0][j][1]); o.y = pack2(acc[0][j][2], acc[0][j][3]);
        *(uint2*)(VB + v * 200 + i0) = o;
        uint2 o2; o2.x = pack2(acc[0][j][0] * e2[i0], acc[0][j][1] * e2[i0 + 1]); o2.y = pack2(acc[0][j][2] * e2[i0 + 2], acc[0][j][3] * e2[i0 + 3]);
        *(uint2*)(V2T + v * 72 + i0) = o2;
      }
    }
    __syncthreads();
    {
      f32x4 acc[1][2]; acc[0][0] = (f32x4){0.f, 0.f, 0.f, 0.f}; acc[0][1] = acc[0][0];
      lds_mma<1, 2, 192>(PQ, 200, VB, 200, m0, n0, acc, lane);
#pragma unroll
      for (int r = 0; r < 4; ++r) {
        const int i = m0 + quad * 4 + r;
        const int n = scan2nat(c * 64 + i, dir);
        bf16_t* orow = ob + ((size_t)b * NTB + n) * DM + 512 + h * 128 + vs * 64 + n0 + l15;
        orow[0] = f2bf(acc[0][0][r]); orow[16] = f2bf(acc[0][1][r]);
      }
    }
    {
      const float ge = __expf(gl);
#pragma unroll
      for (int j = 0; j < 4; ++j) S[0][j] *= ge;
      lds_mma<1, 4, 64>(KT, 72, V2T, 72, wave * 16, 0, S, lane);
    }
    __syncthreads();
#pragma unroll
    for (int j = 0; j < 4; ++j) {
      const int v = j * 16 + l15, d = wave * 16 + quad * 4;
      uint2 uu; uu.x = pack2(S[0][j][0], S[0][j][1]); uu.y = pack2(S[0][j][2], S[0][j][3]);
      *(uint2*)(VB + v * 200 + 64 + d) = uu;
    }
  }
  __syncthreads();
}

#ifndef NAIVE_EVEN
#define NAIVE_EVEN 0
#endif
#ifndef NAIVE_ODD
#define NAIVE_ODD 0
#endif
__device__ __forceinline__ void chains_phase(const Params& p, int layer, char* lds) {
  const int wave = threadIdx.x >> 6;
  float* wl = (float*)(lds + wave * 2048);
  const int item = blockIdx.x + gridDim.x * wave;
  if (layer & 1) {
#if NAIVE_ODD
    if (item >= 512) { chain_idle(); return; }
    if (item < 256) chain_gla(p, layer, item, wl); else chain_gdn(p, layer, item - 256, wl);
#else
    for (int it = blockIdx.x; it < 256; it += gridDim.x) {
      if (it < 128) cgla(p, layer, it, lds); else cgdn(p, layer, it - 128, lds);
    }
#endif
  } else {
#if NAIVE_EVEN
    if (item >= 384) { chain_idle(); return; }
    if (item < 128) chain_ret(p, layer, item, wl); else chain_lru(p, layer, item - 128, wl);
#else
    for (int it = blockIdx.x; it < 256; it += gridDim.x) {
      if (it < 128) cret(p, layer, it, lds); else clru(p, layer, it - 128, lds);
    }
#endif
  }
}

__device__ __forceinline__ void combine_phase(const Params& p, int layer) {
  const int tid = otid(), lane = tid & 63, wave = __builtin_amdgcn_readfirstlane(tid >> 6);
  const int odd = layer & 1;
  const bf16_t* proj = (const bf16_t*)(p.ws + OFF_BIG);
  bf16_t* zf = (bf16_t*)(p.ws + OFF_BUFB);
  const bf16_t* zr = (const bf16_t*)(p.ws + OFF_BUFA);
  const int ldp = odd ? OD_IN : EV_IN;
#pragma unroll 1
  for (int u = blockIdx.x * 8 + wave; u < TT * 2; u += gridDim.x * 8) {
    const int g = u >> 1, hh = u & 1;
    const int c = hh * 512 + lane * 8;
    int gcol;
    if (!odd) gcol = hh ? (2048 + (c - 512)) : (512 + c);
    else gcol = hh ? (4096 + (c - 512)) : (2048 + c);
    const uint4 a4 = *(const uint4*)(zf + (size_t)g * DM + c);
    const uint4 b4 = *(const uint4*)(zr + (size_t)g * DM + c);
    const uint4 g4 = *(const uint4*)(proj + (size_t)g * ldp + gcol);
    float o[8], gt[8], y[8];
    unpack8(a4, o); unpack8(b4, y); unpack8(g4, gt);
#pragma unroll
    for (int j = 0; j < 8; ++j) o[j] += y[j];
    if (!odd && hh == 0) {
#pragma unroll
      for (int j = 0; j < 8; ++j) y[j] = o[j] * gelu_tanh(gt[j]);
    } else {
      if (!odd) {
        float s = 0.f;
#pragma unroll
        for (int j = 0; j < 8; ++j) s += o[j];
        s = row16_sum(s);
        const float mean = s * (1.f / 128.f);
#pragma unroll
        for (int j = 0; j < 8; ++j) o[j] -= mean;
      }
      float ss = 0.f;
#pragma unroll
      for (int j = 0; j < 8; ++j) ss += o[j] * o[j];
      ss = row16_sum(ss);
      const float rs = rsqrtf(ss * (1.f / 128.f) + 1e-6f);
#pragma unroll
      for (int j = 0; j < 8; ++j) y[j] = o[j] * rs * siluf_(gt[j]);
    }
    *(uint4*)(zf + (size_t)g * DM + c) = pack8(y);
  }
}

#define XB_TMO      128
#define XB_XCNT(j)  (256  + 64 * (j))
#define XB_XSUB(j)  (1280 + 64 * (j))
#define XB_XGEN(j)  (2304 + 64 * (j))
#define XB_TOP      3328
#define XB_TOPGEN   3392
#define XCD_BAR_WORDS 3456
#define XB_SPIN_CAP (1u << 18)
#define LAS __attribute__((address_space(3)))
#define OFF_BAR 508755968ull
__device__ __forceinline__ unsigned xb_ld(unsigned* p)              { return __hip_atomic_load(p, __ATOMIC_RELAXED, __HIP_MEMORY_SCOPE_AGENT); }
__device__ __forceinline__ unsigned xb_add(unsigned* p, unsigned v) { return __hip_atomic_fetch_add(p, v, __ATOMIC_RELAXED, __HIP_MEMORY_SCOPE_AGENT); }
__device__ __forceinline__ unsigned xb_xcc_id() { return (unsigned)__builtin_amdgcn_s_getreg((3 << 11) | 20) & 0xFu; }
#define XB_SPIN(cond, bar) do { unsigned _sp = 0; while (cond) { __builtin_amdgcn_s_sleep(1); \
    if ((++_sp & 255u) == 0u) { if (xb_ld(&(bar)[XB_TMO])) break; if (_sp > XB_SPIN_CAP) { atomicAdd(&(bar)[XB_TMO], 1u); break; } } } } while (0)
struct XcdBarrier { unsigned* bar; unsigned x; volatile LAS unsigned* st; };
__device__ __forceinline__ XcdBarrier xcd_barrier_post(unsigned* bar, volatile LAS unsigned* st) {
  XcdBarrier b; b.bar = bar; b.x = xb_xcc_id(); b.st = st;
  if (threadIdx.x == 0) (void)xb_add(&bar[XB_XCNT(b.x)], 1u);
  return b;
}
__device__ __forceinline__ void xcd_barrier_complete(unsigned* bar, unsigned x, unsigned& nloc, unsigned& nx) {
  const unsigned G = gridDim.x * gridDim.y * gridDim.z;
  unsigned sum, cnt, mine, sp = 0u;
  for (;;) {
    sum = 0u; cnt = 0u; mine = 0u;
#pragma unroll
    for (unsigned j = 0; j < 16; ++j) { const unsigned c = xb_ld(&bar[XB_XCNT(j)]); sum += c; cnt += (c > 0u) ? 1u : 0u; mine = (j == x) ? c : mine; }
    if (sum == G) break;
    __builtin_amdgcn_s_sleep(1);
    if ((++sp & 255u) == 0u) { if (xb_ld(&bar[XB_TMO])) break; if (sp > XB_SPIN_CAP) { atomicAdd(&bar[XB_TMO], 1u); break; } }
  }
  nloc = mine > 0u ? mine : 1u; nx = cnt > 0u ? cnt : 1u;
}
__device__ __forceinline__ void xcd_barrier_(const XcdBarrier& b) {
  asm volatile("s_waitcnt vmcnt(0)" ::: "memory");
  __syncthreads();
  if (threadIdx.x == 0) {
    unsigned* bar = b.bar;
    __builtin_amdgcn_s_waitcnt(0);
    unsigned nloc = b.st[0], nx = b.st[1];
    if (nloc == 0u) { xcd_barrier_complete(bar, b.x, nloc, nx); b.st[0] = nloc; b.st[1] = nx; }
    const unsigned old = xb_add(&bar[XB_XSUB(b.x)], 1u);
    const unsigned gen = old / nloc;
    if (old + 1u == (gen + 1u) * nloc) {
      __builtin_amdgcn_fence(__ATOMIC_RELEASE, "agent");
      asm volatile("s_waitcnt vmcnt(0)" ::: "memory");
      const unsigned og = xb_add(&bar[XB_TOP], 1u);
      const unsigned tg = og / nx;
      if (og + 1u == (tg + 1u) * nx) xb_add(&bar[XB_TOPGEN], 1u);
      else XB_SPIN(xb_ld(&bar[XB_TOPGEN]) == tg, bar);
      __builtin_amdgcn_fence(__ATOMIC_ACQUIRE, "agent");
      xb_add(&bar[XB_XGEN(b.x)], 1u);
      asm volatile("s_waitcnt vmcnt(0)" ::: "memory");
    } else {
      XB_SPIN(xb_ld(&bar[XB_XGEN(b.x)]) == gen, bar);
      __builtin_amdgcn_fence(__ATOMIC_ACQUIRE, "agent");
      asm volatile("s_waitcnt vmcnt(0)" ::: "memory");
    }
  }
  __syncthreads();
}

__device__ __forceinline__ void xcd_barrier(const Params& p, char* lds) {
  XcdBarrier b; b.bar = (unsigned*)(p.ws + OFF_BAR); b.x = xb_xcc_id(); b.st = (volatile LAS unsigned*)(LAS char*)(lds + LDS_BYTES - 16);
  xcd_barrier_(b);
}

__global__ void __launch_bounds__(NTHREADS) mega(Params p) {
  extern __shared__ __attribute__((aligned(16))) char lds[];
  cg::grid_group grid = cg::this_grid();
  volatile LAS unsigned* xst = (volatile LAS unsigned*)(LAS char*)(lds + LDS_BYTES - 16);
  if (threadIdx.x == 0) { xst[0] = 0u; xst[1] = 0u; }
  __syncthreads();
  (void)xcd_barrier_post((unsigned*)(p.ws + OFF_BAR), xst);
  phase0(p, lds);
  grid.sync();
  bf16_t* bufA = (bf16_t*)(p.ws + OFF_BUFA);
  bf16_t* bufB = (bf16_t*)(p.ws + OFF_BUFB);
  bf16_t* big = (bf16_t*)(p.ws + OFF_BIG);
  bf16_t* wb = (bf16_t*)(p.ws + OFF_W);
  for (int layer = 0; layer < 4; ++layer) {
    const float* mod = (const float*)(p.ws + OFF_MOD) + (size_t)layer * 9 * 6144;
    const int nin = (layer & 1) ? OD_IN : EV_IN;
    norm_phase(p, layer, 0);
    convert_weights(p, layer, lds);
    xcd_barrier(p, lds);
    gemm_phase<0>(p, bufA, DM, wb + WO_IN, nin, 1024, big, nin, nullptr, lds);
    xcd_barrier(p, lds);
    if (layer & 1) { gdn_prep_phase(p, layer, lds); xcd_barrier(p, lds); }
    chains_phase(p, layer, lds);
    xcd_barrier(p, lds);
    combine_phase(p, layer);
    xcd_barrier(p, lds);
    gemm_phase<2>(p, bufB, DM, wb + WO_OUT, 1024, 1024, nullptr, 0, mod + 2 * 1024, lds, layer == 0);
    xcd_barrier(p, lds);
    norm_phase(p, layer, 1);
    xcd_barrier(p, lds);
    gemm_phase<1>(p, bufA, DM, wb + WO_W1, DFF, 1024, big, DFF, nullptr, lds);
    xcd_barrier(p, lds);
    gemm_phase<2>(p, big, DFF, wb + WO_W2, 1024, 4096, nullptr, 0, mod + 5 * 1024, lds);
    xcd_barrier(p, lds);
  }
  final_norm(p);
}

extern "C" void kernel_launch(void* const* d_in, const int* in_sizes, int n_in, void* d_out, int out_size, void* d_ws, size_t ws_size,
                              hipStream_t stream) {
  static int grid_blocks = 0;
  if (!grid_blocks) {
    int dev = 0, cus = 0, per_cu = 0;
    hipGetDevice(&dev);
    hipDeviceGetAttribute(&cus, hipDeviceAttributeMultiprocessorCount, dev);
    hipFuncSetAttribute((const void*)mega, hipFuncAttributeMaxDynamicSharedMemorySize, LDS_BYTES);
    hipOccupancyMaxActiveBlocksPerMultiprocessor(&per_cu, (const void*)mega, NTHREADS, LDS_BYTES);
    if (per_cu < 1) per_cu = 1;
    if (per_cu > 1) per_cu = 1;
    if (cus < 1) cus = 256;
    grid_blocks = cus * per_cu;
  }
  Params p{};
  for (int i = 0; i < 26; ++i) p.in[i] = (const float*)d_in[i];
  p.out = (float*)d_out;
  p.ws = (unsigned char*)d_ws;
  (void)hipMemsetAsync((char*)d_ws + OFF_BAR, 0, XCD_BAR_WORDS * 4, stream);
  void* args[] = {&p};
  hipError_t e = hipLaunchCooperativeKernel((const void*)mega, dim3(grid_blocks), dim3(NTHREADS), args, LDS_BYTES, stream);
  if (e != hipSuccess) fprintf(stderr, "cooperative launch failed: %s (grid %d)\n", hipGetErrorString(e), grid_blocks);
}
```

```cpp
#include <hip/hip_runtime.h>
#include <hip/hip_cooperative_groups.h>
#include <cstdio>
namespace cg = cooperative_groups;

typedef unsigned short bf16_t;
using bf16x8 = __attribute__((ext_vector_type(8))) short;
using f32x4 = __attribute__((ext_vector_type(4))) float;

#define NTB 4352
#define TT 34816
#define DM 1024
#define DFF 4096
#define EV_IN 2560
#define OD_IN 4624
#define NTHREADS 512
#define LDS_BYTES 157696

#define OFF_XC   0ull
#define OFF_MOD  8388608ull
#define OFF_ROPE 9437184ull
#define OFF_W    10485760ull
#define OFF_BUFA 41943040ull
#define OFF_BUFB 113246208ull
#define OFF_BIG  184549376ull
#define WO_IN   0
#define WO_OUT  4849664
#define WO_W1   5898240
#define WO_W2   10092544

struct Params {
  const float* in[26];
  float* out;
  unsigned char* ws;
};

__device__ __forceinline__ float bf2f(bf16_t u) { return __uint_as_float(((unsigned)u) << 16); }
typedef __bf16 bf16x2_t __attribute__((ext_vector_type(2)));
__device__ __forceinline__ bf16_t f2bf(float f) { return __builtin_bit_cast(unsigned short, (__bf16)f); }
__device__ __forceinline__ unsigned pack2(float a, float b) { bf16x2_t v = {(__bf16)a, (__bf16)b}; return __builtin_bit_cast(unsigned, v); }
__device__ __forceinline__ float frcp_(float x) { return __builtin_amdgcn_rcpf(x); }
__device__ __forceinline__ float sigmoidf_(float x) { return frcp_(1.f + __expf(-x)); }
__device__ __forceinline__ float siluf_(float x) { return x * sigmoidf_(x); }
__device__ __forceinline__ float gelu_tanh(float x) {
  const float u = 0.7978845608028654f * (x + 0.044715f * x * x * x);
  const float t = 1.f - 2.f * frcp_(1.f + __expf(2.f * u));
  return 0.5f * x * (1.f + t);
}
__device__ __forceinline__ float softplusf_(float x) { return fmaxf(x, 0.f) + __logf(1.f + __expf(-fabsf(x))); }
template <int CTRL> __device__ __forceinline__ float dppf(float v) {
  return __int_as_float(__builtin_amdgcn_update_dpp(0, __float_as_int(v), CTRL, 0xF, 0xF, true));
}
__device__ __forceinline__ float quad_sum(float v) { v += dppf<0xB1>(v); v += dppf<0x4E>(v); return v; }
__device__ __forceinline__ float oct_sum(float v) { v = quad_sum(v); v += dppf<0x141>(v); return v; }
__device__ __forceinline__ float row16_sum(float v) { v = oct_sum(v); v += dppf<0x140>(v); return v; }
__device__ __forceinline__ float wave_sum(float v) {
  v = row16_sum(v);
  return __builtin_amdgcn_readlane(v, 0) + __builtin_amdgcn_readlane(v, 16) + __builtin_amdgcn_readlane(v, 32) + __builtin_amdgcn_readlane(v, 48);
}
__device__ __forceinline__ int otid() { int t = threadIdx.x; asm volatile("" : "+v"(t)); return t; }
__device__ __forceinline__ float* xrow(const Params& p, int g) {
  int b = g / NTB, n = g - b * NTB;
  return n < 256 ? ((float*)(p.ws + OFF_XC) + (size_t)(b * 256 + n) * DM) : (p.out + (size_t)(b * 4096 + (n - 256)) * DM);
}
__device__ __forceinline__ const float* xrow_src(const Params& p, int g, bool first) {
  int b = g / NTB, n = g - b * NTB;
  if (first) return n < 256 ? (p.in[2] + (size_t)(b * 256 + n) * DM) : (p.in[0] + (size_t)(b * 4096 + (n - 256)) * DM);
  return n < 256 ? ((const float*)(p.ws + OFF_XC) + (size_t)(b * 256 + n) * DM) : (p.out + (size_t)(b * 4096 + (n - 256)) * DM);
}
__device__ __forceinline__ int scan2nat(int pos, int dir) { return dir ? (pos < 256 ? 255 - pos : 4607 - pos) : pos; }

__device__ __forceinline__ void phase0(const Params& p, char* lds) {
  const int tid = threadIdx.x, lane = tid & 63, wave = tid >> 6;
  float* sv = (float*)lds;
  float* red = (float*)(lds + 36864);
  const float* c = p.in[1];
  const float* cctx = p.in[3];
  for (int i = tid; i < 9 * 1024; i += NTHREADS) {
    float v = (i < 8192) ? c[i] : cctx[i - 8192];
    sv[i] = siluf_(v);
  }
  __syncthreads();
  float* mod = (float*)(p.ws + OFF_MOD);
  for (int it = blockIdx.x; it < 4 * 96; it += gridDim.x) {
    int l = it / 96, cg_ = it % 96;
    int col = cg_ * 64 + lane;
    const float* W = p.in[4] + (size_t)l * 1024 * 6144 + col;
    float acc[9];
#pragma unroll
    for (int r = 0; r < 9; ++r) acc[r] = 0.f;
#pragma unroll 8
    for (int k = wave * 128; k < wave * 128 + 128; ++k) {
      float w = W[(size_t)k * 6144];
#pragma unroll
      for (int r = 0; r < 9; ++r) acc[r] += sv[r * 1024 + k] * w;
    }
#pragma unroll
    for (int r = 0; r < 9; ++r) red[(wave * 9 + r) * 64 + lane] = acc[r];
    __syncthreads();
    for (int i = tid; i < 9 * 64; i += NTHREADS) {
      int r = i / 64, cc = i % 64;
      float s = 0.f;
#pragma unroll
      for (int w = 0; w < 8; ++w) s += red[(w * 9 + r) * 64 + cc];
      int colo = cg_ * 64 + cc;
      mod[((size_t)l * 9 + r) * 6144 + colo] = s + p.in[5][l * 6144 + colo];
    }
    __syncthreads();
  }
  const size_t gt = (size_t)blockIdx.x * NTHREADS + tid, gs = (size_t)gridDim.x * NTHREADS;
  float* ct = (float*)(p.ws + OFF_ROPE); float* st = ct + 4096 * 32;
  for (size_t i = gt; i < 4096 * 32; i += gs) {
    int t = (int)(i >> 5), pp = (int)(i & 31);
    int f = pp & 15;
    float inv = powf(10000.f, -(float)f / 16.f);
    float pos = (pp < 16) ? (float)(t >> 6) : (float)(t & 63);
    float ang = pos * inv;
    ct[i] = cosf(ang); st[i] = sinf(ang);
  }
}

__device__ __forceinline__ void norm_phase(const Params& p, int layer, int which) {
  const int tid = otid(), lane = tid & 63, wave = tid >> 6;
  const float* g = (which ? p.in[7] : p.in[6]) + layer * DM;
  const float* mod = (const float*)(p.ws + OFF_MOD) + (size_t)layer * 9 * 6144;
  bf16_t* dst = (bf16_t*)(p.ws + OFF_BUFA);
  for (int row = blockIdx.x * 8 + wave; row < TT; row += gridDim.x * 8) {
    int b = row / NTB, n = row - b * NTB;
    int r = n < 256 ? 8 : b;
    const float* x = xrow_src(p, row, layer == 0 && which == 0);
    const float* sh = mod + (size_t)r * 6144 + (which ? 3 : 0) * 1024;
    const float* sc = sh + 1024;
    float4 v[4]; float ss = 0.f;
#pragma unroll
    for (int i = 0; i < 4; ++i) { v[i] = *(const float4*)(x + i * 256 + lane * 4); ss += v[i].x * v[i].x + v[i].y * v[i].y + v[i].z * v[i].z + v[i].w * v[i].w; }
    ss = wave_sum(ss);
    float rstd = rsqrtf(ss * (1.f / 1024.f) + 1e-6f);
#pragma unroll
    for (int i = 0; i < 4; ++i) {
      int cidx = i * 256 + lane * 4;
      float4 gg = *(const float4*)(g + cidx), s1 = *(const float4*)(sc + cidx), s0 = *(const float4*)(sh + cidx);
      float a0 = v[i].x * rstd * gg.x * (1.f + s1.x) + s0.x;
      float a1 = v[i].y * rstd * gg.y * (1.f + s1.y) + s0.y;
      float a2 = v[i].z * rstd * gg.z * (1.f + s1.z) + s0.z;
      float a3 = v[i].w * rstd * gg.w * (1.f + s1.w) + s0.w;
      uint2 o; o.x = pack2(a0, a1); o.y = pack2(a2, a3);
      *(uint2*)(dst + (size_t)row * DM + cidx) = o;
    }
  }
}

__device__ __forceinline__ void final_norm(const Params& p) {
  const int tid = otid(), lane = tid & 63, wave = tid >> 6;
  const float* g = p.in[25];
  for (int row = blockIdx.x * 8 + wave; row < 8 * 4096; row += gridDim.x * 8) {
    float* x = p.out + (size_t)row * DM;
    float4 v[4]; float ss = 0.f;
#pragma unroll
    for (int i = 0; i < 4; ++i) { v[i] = *(const float4*)(x + i * 256 + lane * 4); ss += v[i].x * v[i].x + v[i].y * v[i].y + v[i].z * v[i].z + v[i].w * v[i].w; }
    ss = wave_sum(ss);
    float rstd = rsqrtf(ss * (1.f / 1024.f) + 1e-6f);
#pragma unroll
    for (int i = 0; i < 4; ++i) {
      int cidx = i * 256 + lane * 4;
      float4 gg = *(const float4*)(g + cidx);
      float4 o; o.x = v[i].x * rstd * gg.x; o.y = v[i].y * rstd * gg.y; o.z = v[i].z * rstd * gg.z; o.w = v[i].w * rstd * gg.w;
      *(float4*)(x + cidx) = o;
    }
  }
}

__device__ __forceinline__ void convert_weights(const Params& p, int layer, char* lds) {
  const int tid = otid();
  bf16_t* Tl = (bf16_t*)lds;
  bf16_t* wbase = (bf16_t*)(p.ws + OFF_W);
  const int odd = layer & 1;
  const float* srcs[4]; int Ks[4], Ns[4]; bf16_t* dsts[4]; int cnt[4];
  srcs[0] = odd ? p.in[20] + (size_t)(layer >> 1) * 1024 * OD_IN : p.in[11] + (size_t)(layer >> 1) * 1024 * EV_IN;
  Ks[0] = 1024; Ns[0] = odd ? OD_IN : EV_IN; dsts[0] = wbase + WO_IN;
  srcs[1] = p.in[8] + (size_t)layer * 1024 * 1024; Ks[1] = 1024; Ns[1] = 1024; dsts[1] = wbase + WO_OUT;
  srcs[2] = p.in[9] + (size_t)layer * 1024 * 4096; Ks[2] = 1024; Ns[2] = 4096; dsts[2] = wbase + WO_W1;
  srcs[3] = p.in[10] + (size_t)layer * 4096 * 1024; Ks[3] = 4096; Ns[3] = 1024; dsts[3] = wbase + WO_W2;
  int total = 0;
#pragma unroll
  for (int i = 0; i < 4; ++i) { cnt[i] = (Ks[i] / 64) * ((Ns[i] + 63) / 64); total += cnt[i]; }
  for (int it = blockIdx.x; it < total; it += gridDim.x) {
    int r = it, mi = 0;
    if (r >= cnt[0]) { r -= cnt[0]; mi = 1; if (r >= cnt[1]) { r -= cnt[1]; mi = 2; if (r >= cnt[2]) { r -= cnt[2]; mi = 3; } } }
    const float* W = mi == 0 ? srcs[0] : mi == 1 ? srcs[1] : mi == 2 ? srcs[2] : srcs[3];
    const int K = mi == 3 ? 4096 : 1024;
    const int N = mi == 0 ? Ns[0] : mi == 1 ? 1024 : mi == 2 ? 4096 : 1024;
    bf16_t* D = mi == 0 ? dsts[0] : mi == 1 ? dsts[1] : mi == 2 ? dsts[2] : dsts[3];
    const int ntn = (N + 63) / 64;
    const int kt = r / ntn, nt = r % ntn;
    const int k0 = kt * 64, n0 = nt * 64;
    {
      const int rr = tid >> 4, c4 = (tid & 15) * 4;
#pragma unroll
      for (int ps = 0; ps < 2; ++ps) {
        int k = k0 + rr + 32 * ps, n = n0 + c4;
        float4 v = make_float4(0.f, 0.f, 0.f, 0.f);
        if (n < N) v = *(const float4*)(W + (size_t)k * N + n);
        Tl[(c4 + 0) * 72 + rr + 32 * ps] = f2bf(v.x);
        Tl[(c4 + 1) * 72 + rr + 32 * ps] = f2bf(v.y);
        Tl[(c4 + 2) * 72 + rr + 32 * ps] = f2bf(v.z);
        Tl[(c4 + 3) * 72 + rr + 32 * ps] = f2bf(v.w);
      }
    }
    __syncthreads();
    {
      const int nr = tid >> 3, kc = tid & 7;
      if (n0 + nr < N) *(uint4*)(D + (size_t)(n0 + nr) * K + k0 + kc * 8) = *(const uint4*)(Tl + nr * 72 + kc * 8);
    }
    __syncthreads();
  }
}

template <int KS> __device__ __forceinline__ int lds_byte(int r, int c) {
  int st = (r >> 4) * KS + (c >> 5), ob = (r & 15) * 64 + (c & 31) * 2;
  return st * 1024 + (ob ^ (((ob >> 9) & 1) << 5));
}
template <int KS> __device__ __forceinline__ void stage_rc(int b, int& R, int& C) {
  int st = b >> 10, sb = b & 1023, swz = sb ^ (((sb >> 9) & 1) << 5);
  R = (st / KS) * 16 + swz / 64;
  C = (st % KS) * 32 + (swz % 64) / 2;
}
#define WAIT_V0() asm volatile("s_waitcnt vmcnt(0)" ::: "memory")

template <int EPI>
__device__ __forceinline__ void gemm_phase(const Params& p, const bf16_t* __restrict__ A, int lda_unused, const bf16_t* __restrict__ Bt, int N, int K,
                           bf16_t* outb, int ldo, const float* modv, char* lds, bool first = false) {
  constexpr int KS = 2, BK = 64, TA_B = 272 * BK * 2, TB_B = 256 * BK * 2, STAGE_B = TA_B + TB_B, NPASS = 9;
  const int tid = otid(), lane = tid & 63, wid = __builtin_amdgcn_readfirstlane(tid >> 6);
  const int fr = lane & 15, fq = lane >> 4;
  const int wr = wid >> 2, wc = wid & 3, rbase = wr * 144;
  const int nM = TT / 272, nN = (N + 255) / 256, nwg = nM * nN;
  const int nt = K / BK;
  int sR[NPASS], sC[NPASS];
#pragma unroll
  for (int i = 0; i < NPASS; ++i) {
    const int s = i * 8 + wid;
    const int sl = s < 34 ? s : s - 34;
    stage_rc<KS>(sl * 1024 + lane * 16, sR[i], sC[i]);
  }
  int so[NPASS];
  const bf16_t* Ab = A;
  int nbrow = 0, nbcol = 0;
#define TILE_COORDS(w) do { int wgid = (w); \
      { int q = nwg / 8, r = nwg % 8, xcd = wgid % 8, off = wgid / 8; \
        wgid = (xcd < r ? xcd * (q + 1) : r * (q + 1) + (xcd - r) * q) + off; } \
      const int nig = 4 * nN, gid = wgid / nig, fm = gid * 4, gsz = min(nM - fm, 4); \
      nbrow = (fm + ((wgid % nig) % gsz)) * 272; nbcol = ((wgid % nig) / gsz) * 256; \
      Ab = A + (size_t)nbrow * K; \
      _Pragma("unroll") for (int i = 0; i < NPASS; ++i) { const int s = i * 8 + wid; \
        if (s < 34) so[i] = (sR[i] * K + sC[i]) * 2; \
        else { int br = nbcol + sR[i]; if (br > N - 1) br = N - 1; so[i] = (br * K + sC[i]) * 2; } } } while (0)
#define GLDS_PART(buf, kt, i_lo, i_hi) do { const char* ga_ = (const char*)(Ab + (kt) * BK); const char* gb_ = (const char*)(Bt + (kt) * BK); \
    _Pragma("unroll") for (int i = (i_lo); i < (i_hi); ++i) { const int s = i * 8 + wid; \
      if (s < 66) __builtin_amdgcn_global_load_lds((const unsigned*)((s < 34 ? ga_ : gb_) + (unsigned)so[i]), (unsigned*)(lds + (buf) * STAGE_B + s * 1024), 16, 0, 0); } } while (0)
#define GLDS_STAGE(buf, kt) GLDS_PART(buf, kt, 0, NPASS)
  int w0 = blockIdx.x;
  if (w0 < nwg) { TILE_COORDS(w0); GLDS_STAGE(0, 0); }
  while (w0 < nwg) {
    const int brow = nbrow, bcol = nbcol;
    f32x4 acc[9][4];
#pragma unroll
    for (int m = 0; m < 9; ++m)
#pragma unroll
      for (int n = 0; n < 4; ++n) acc[m][n] = (f32x4){0.f, 0.f, 0.f, 0.f};
    WAIT_V0(); __syncthreads();
#pragma unroll 1
    for (int t = 0; t < nt; ++t) {
      const int cur = t & 1;
      const int tn = (t + 1 < nt) ? t + 1 : t;
      const char* sa = lds + cur * STAGE_B; const char* sb = sa + TA_B;
#pragma unroll
      for (int ks = 0; ks < KS; ++ks) {
        bf16x8 Bf[4], a0, a1;
#pragma unroll
        for (int n = 0; n < 4; ++n) Bf[n] = *(const bf16x8*)(sb + lds_byte<KS>(wc * 64 + n * 16 + fr, ks * 32 + fq * 8));
        a0 = *(const bf16x8*)(sa + lds_byte<KS>(rbase + fr, ks * 32 + fq * 8));
#pragma unroll
        for (int m = 0; m < 8; ++m) {
          if (m < 7 || wr == 0) a1 = *(const bf16x8*)(sa + lds_byte<KS>(rbase + (m + 1) * 16 + fr, ks * 32 + fq * 8));
          if (ks == 0) { if (m < 5) GLDS_PART(cur ^ 1, tn, m, m + 1); } else { if (m < 4) GLDS_PART(cur ^ 1, tn, 5 + m, 6 + m); }
          __builtin_amdgcn_s_setprio(1);
#pragma unroll
          for (int n = 0; n < 4; ++n) acc[m][n] = __builtin_amdgcn_mfma_f32_16x16x32_bf16(Bf[n], a0, acc[m][n], 0, 0, 0);
          __builtin_amdgcn_s_setprio(0);
          a0 = a1;
        }
        if (wr == 0) {
#pragma unroll
          for (int n = 0; n < 4; ++n) acc[8][n] = __builtin_amdgcn_mfma_f32_16x16x32_bf16(Bf[n], a0, acc[8][n], 0, 0, 0);
        }
      }
      WAIT_V0(); __syncthreads();
    }
    w0 += gridDim.x;
    if (w0 < nwg) { TILE_COORDS(w0); GLDS_STAGE(0, 0); }
    char* est = lds + STAGE_B + wid * 6912;
    if (EPI == 0 || EPI == 1) {
#pragma unroll
      for (int pi = 0; pi < 3; ++pi) {
#pragma unroll
        for (int mm = 0; mm < 3; ++mm) {
          const int m = pi * 3 + mm;
          if (m < 8 || wr == 0) {
#pragma unroll
            for (int n = 0; n < 4; ++n) {
              f32x4 v = acc[m][n];
              if (EPI == 1) {
#pragma unroll
                for (int j = 0; j < 4; ++j) { const float a = fmaxf(v[j], 0.f); v[j] = a * a; }
              }
              uint2 o; o.x = pack2(v[0], v[1]); o.y = pack2(v[2], v[3]);
              *(uint2*)(est + (mm * 16 + fr) * 144 + (n * 16 + fq * 4) * 2) = o;
            }
          }
        }
        asm volatile("" ::: "memory");
        const int nrows = (wr == 0 || pi < 2) ? 48 : 32;
#pragma unroll
        for (int q = 0; q < 6; ++q) {
          const int idx = q * 64 + lane, rl = idx >> 3, ch = idx & 7;
          const uint4 val = *(const uint4*)(est + rl * 144 + ch * 16);
          const int row = brow + rbase + pi * 48 + rl, col = bcol + wc * 64 + ch * 8;
          if (rl < nrows && col < N) *(uint4*)(outb + (size_t)row * ldo + col) = val;
        }
        asm volatile("" ::: "memory");
      }
    } else {
      const int ch = lane & 15, rq4 = lane >> 4;
      const int col = bcol + wc * 64 + ch * 4;
      const int bidx0 = brow / NTB;
      const float4 md_lat = *(const float4*)(modv + (size_t)bidx0 * 6144 + col);
      float4 xc[4], xn[4];
#pragma unroll
      for (int q = 0; q < 4; ++q) xc[q] = *(const float4*)(xrow_src(p, brow + rbase + q * 4 + rq4, first) + col);
#pragma unroll
      for (int m = 0; m < 9; ++m) {
        if (m < 8 || wr == 0) {
#pragma unroll
          for (int n = 0; n < 4; ++n) *(f32x4*)(est + fr * 272 + (n * 16 + fq * 4) * 4) = acc[m][n];
          if (m < 7 || (m == 7 && wr == 0)) {
#pragma unroll
            for (int q = 0; q < 4; ++q) xn[q] = *(const float4*)(xrow_src(p, brow + rbase + (m + 1) * 16 + q * 4 + rq4, first) + col);
          }
          asm volatile("" ::: "memory");
#pragma unroll
          for (int q = 0; q < 4; ++q) {
            const int rl = q * 4 + rq4;
            const float4 v = *(const float4*)(est + rl * 272 + ch * 16);
            const int row = brow + rbase + m * 16 + rl;
            const bool isctx = (row - bidx0 * NTB) < 256;
            float4 md = md_lat;
            if (isctx) md = *(const float4*)(modv + (size_t)8 * 6144 + col);
            float4 cur = xc[q];
            cur.x += md.x * v.x; cur.y += md.y * v.y; cur.z += md.z * v.z; cur.w += md.w * v.w;
            *(float4*)(xrow(p, row) + col) = cur;
          }
#pragma unroll
          for (int q = 0; q < 4; ++q) xc[q] = xn[q];
          asm volatile("" ::: "memory");
        }
      }
    }
  }
}

#undef GLDS_STAGE
#undef GLDS_PART
#undef TILE_COORDS

__device__ void chain_idle() {
  for (int pos = 0; pos < NTB; ++pos) { __syncthreads(); __syncthreads(); }
}

__device__ void chain_ret(const Params& p, int layer, int item, float* wl) {
  const int lane = otid() & 63;
  const int b = item >> 4, h = (item >> 2) & 3, dir = (item >> 1) & 1, vs = item & 1;
  const int e = layer >> 1;
  const bf16_t* proj = (const bf16_t*)(p.ws + OFF_BIG);
  bf16_t* ob = (bf16_t*)(p.ws + (dir ? OFF_BUFA : OFF_BUFB));
  const float* ct = (const float*)(p.ws + OFF_ROPE); const float* st = ct + 4096 * 32;
  const float gam = expf(p.in[19][(e * 2 + dir) * 4 + h]);
  float s[64];
#pragma unroll
  for (int d = 0; d < 64; ++d) s[d] = 0.f;
  float2* qk = (float2*)wl;
  for (int pos = 0; pos < NTB; ++pos) {
    const int n = scan2nat(pos, dir);
    const size_t g = (size_t)b * NTB + n;
    const bf16_t* row = proj + g * EV_IN;
    float qv = bf2f(row[1024 + h * 64 + lane]);
    float kv = bf2f(row[1280 + h * 64 + lane]) * 0.125f;
    float vv = bf2f(row[1536 + h * 128 + vs * 64 + lane]);
    float qo = __shfl_xor(qv, 32), ko = __shfl_xor(kv, 32);
    if (n >= 256) {
      int t = n - 256, pp = lane & 31;
      float c = ct[t * 32 + pp], sn = st[t * 32 + pp];
      if (lane < 32) { qv = qv * c - qo * sn; kv = kv * c - ko * sn; }
      else { qv = qo * sn + qv * c; kv = ko * sn + kv * c; }
    }
    qk[lane] = make_float2(qv, kv);
    __syncthreads();
    float o = 0.f;
#pragma unroll
    for (int d = 0; d < 64; d += 2) {
      float4 t4 = *(const float4*)(qk + d);
      s[d] = gam * s[d] + t4.y * vv; o += t4.x * s[d];
      s[d + 1] = gam * s[d + 1] + t4.w * vv; o += t4.z * s[d + 1];
      if ((d & 7) == 6) asm volatile("" ::: "memory");
    }
    ob[g * DM + 512 + h * 128 + vs * 64 + lane] = f2bf(o);
    __syncthreads();
  }
}

__device__ void chain_lru(const Params& p, int layer, int item, float* wl) {
  const int lane = otid() & 63;
  const int part = item & 1, kb = (item >> 1) & 7, dir = (item >> 4) & 1, b = item >> 5;
  const int e = layer >> 1;
  const int dh = lane >> 5, jl = (lane & 31) + 32 * part;
  const int chu = kb * 64 + lane;
  const int cho = kb * 64 + jl;
  const bf16_t* proj = (const bf16_t*)(p.ws + OFF_BIG);
  bf16_t* ob = (bf16_t*)(p.ws + (dir ? OFF_BUFA : OFF_BUFB));
  float cw[4];
#pragma unroll
  for (int t = 0; t < 4; ++t) cw[t] = p.in[12][(e * 4 + t) * 512 + chu];
  const float cb = p.in[13][e * 512 + chu];
  float wa[32], wx[32];
  {
    const float* wap = p.in[14] + ((size_t)((e * 2 + dir) * 8 + kb) * 64 + 32 * dh) * 64 + jl;
    const float* wxp = p.in[16] + ((size_t)((e * 2 + dir) * 8 + kb) * 64 + 32 * dh) * 64 + jl;
#pragma unroll
    for (int i = 0; i < 32; ++i) { wa[i] = wap[i * 64]; wx[i] = wxp[i * 64]; }
  }
  const float ba = p.in[15][(e * 2 + dir) * 512 + cho], bx = p.in[17][(e * 2 + dir) * 512 + cho];
  const float lam = p.in[18][(e * 2 + dir) * 512 + cho];
  const float spc = -8.f * softplusf_(-lam);
  float hst = 0.f;
  const float* wlh = wl + 32 * dh;
  for (int pos = 0; pos < NTB; ++pos) {
    const int n = scan2nat(pos, dir);
    const size_t g = (size_t)b * NTB + n;
    const int lo = n < 256 ? 0 : 256, hi = n < 256 ? 256 : NTB;
    float u = cb;
#pragma unroll
    for (int t = 0; t < 4; ++t) {
      int nn = n + t - 2;
      if (nn >= lo && nn < hi) u += cw[t] * bf2f(proj[((size_t)b * NTB + nn) * EV_IN + chu]);
    }
    wl[lane] = u;
    __syncthreads();
    float rp = 0.f, ip = 0.f;
#pragma unroll
    for (int i = 0; i < 32; i += 4) {
      float4 u4 = *(const float4*)(wlh + i);
      rp += u4.x * wa[i] + u4.y * wa[i + 1] + u4.z * wa[i + 2] + u4.w * wa[i + 3];
      ip += u4.x * wx[i] + u4.y * wx[i + 1] + u4.z * wx[i + 2] + u4.w * wx[i + 3];
    }
    rp += __shfl_xor(rp, 32); ip += __shfl_xor(ip, 32);
    rp += ba; ip += bx;
    float uo = wl[jl];
    float r = sigmoidf_(rp), ig = sigmoidf_(ip);
    float la = spc * r;
    float a = expf(la);
    float bb = sqrtf(-expm1f(2.f * la)) * ig * uo;
    hst = a * hst + bb;
    if (dh == 0) ob[g * DM + cho] = f2bf(hst);
    __syncthreads();
  }
}

__device__ void chain_gla(const Params& p, int layer, int item, float* wl) {
  const int lane = otid() & 63;
  const int vs4 = item & 3, dir = (item >> 2) & 1, h = (item >> 3) & 3, b = item >> 5;
  const int o_ = layer >> 1;
  const int dh = lane >> 5, vl = lane & 31;
  const bf16_t* proj = (const bf16_t*)(p.ws + OFF_BIG);
  bf16_t* ob = (bf16_t*)(p.ws + (dir ? OFF_BUFA : OFF_BUFB));
  float lb[2];
#pragma unroll
  for (int j = 0; j < 2; ++j) {
    int d = h * 128 + lane + 64 * j;
    float l0 = p.in[21][(dir * 2 + 0) * 512 + d], l1 = p.in[21][(dir * 2 + 1) * 512 + d];
    lb[j] = o_ == 0 ? 0.f : 1.f / (1.f + expf(l0 - l1));
  }
  float s[64];
#pragma unroll
  for (int d = 0; d < 64; ++d) s[d] = 0.f;
  float4* st4 = (float4*)wl;
  const float4* st4h = st4 + 64 * dh;
  for (int pos = 0; pos < NTB; ++pos) {
    const int n = scan2nat(pos, dir);
    const size_t g = (size_t)b * NTB + n;
    const bf16_t* row = proj + g * OD_IN;
#pragma unroll
    for (int j = 0; j < 2; ++j) {
      int d = lane + 64 * j;
      float hq = bf2f(row[h * 128 + d]);
      float fp = bf2f(row[(dir ? 1024 : 512) + h * 128 + d]);
      float sg = sigmoidf_(fp);
      float f = lb[j] + (1.f - lb[j]) * sg;
      st4[d] = make_float4(f, 1.f - f, siluf_(hq), 0.f);
    }
    float vv = bf2f(row[1536 + h * 128 + vs4 * 32 + vl]);
    __syncthreads();
    float o = 0.f;
#pragma unroll
    for (int d = 0; d < 64; ++d) {
      float4 t4 = st4h[d];
      s[d] = t4.x * s[d] + t4.y * vv; o += t4.z * s[d];
      if ((d & 3) == 3) asm volatile("" ::: "memory");
    }
    o += __shfl_xor(o, 32);
    if (dh == 0) ob[g * DM + h * 128 + vs4 * 32 + vl] = f2bf(o);
    __syncthreads();
  }
}

__device__ void chain_gdn(const Params& p, int layer, int item, float* wl) {
  const int lane = otid() & 63;
  const int vs4 = item & 3, dir = (item >> 2) & 1, h = (item >> 3) & 3, b = item >> 5;
  const int o_ = layer >> 1;
  const int dh = lane >> 5, vl = lane & 31;
  const bf16_t* proj = (const bf16_t*)(p.ws + OFF_BIG);
  bf16_t* ob = (bf16_t*)(p.ws + (dir ? OFF_BUFA : OFF_BUFB));
  int cch[5], pcol[5];
  cch[0] = h * 128 + lane;        pcol[0] = 2560 + cch[0];
  cch[1] = h * 128 + lane + 64;   pcol[1] = 2560 + cch[1];
  cch[2] = 512 + h * 128 + lane;  pcol[2] = 2560 + cch[2];
  cch[3] = 512 + h * 128 + lane + 64; pcol[3] = 2560 + cch[3];
  cch[4] = 1024 + h * 128 + vs4 * 32 + vl; pcol[4] = 2560 + cch[4];
  float cw[5][4];
#pragma unroll
  for (int j = 0; j < 5; ++j)
#pragma unroll
    for (int t = 0; t < 4; ++t) cw[j][t] = p.in[22][((size_t)o_ * 4 + t) * 1536 + cch[j]];
  const float aexp = expf(p.in[23][(o_ * 2 + dir) * 4 + h]);
  const float dtb = p.in[24][(o_ * 2 + dir) * 4 + h];
  float s[64];
#pragma unroll
  for (int d = 0; d < 64; ++d) s[d] = 0.f;
  float2* qk = (float2*)wl;
  const float2* qkh = qk + 64 * dh;
  for (int pos = 0; pos < NTB; ++pos) {
    const int n = scan2nat(pos, dir);
    const size_t g = (size_t)b * NTB + n;
    const int lo = n < 256 ? 0 : 256, hi = n < 256 ? 256 : NTB;
    float cv[5];
#pragma unroll
    for (int j = 0; j < 5; ++j) cv[j] = 0.f;
#pragma unroll
    for (int t = 0; t < 4; ++t) {
      int nn = n + t - 2;
      if (nn >= lo && nn < hi) {
        const bf16_t* rr = proj + ((size_t)b * NTB + nn) * OD_IN;
#pragma unroll
        for (int j = 0; j < 5; ++j) cv[j] += cw[j][t] * bf2f(rr[pcol[j]]);
      }
    }
#pragma unroll
    for (int j = 0; j < 5; ++j) cv[j] = siluf_(cv[j]);
    float sq = wave_sum(cv[0] * cv[0] + cv[1] * cv[1]);
    float sk = wave_sum(cv[2] * cv[2] + cv[3] * cv[3]);
    float rq = rsqrtf(sq + 1e-6f) * 0.08838834764831845f, rk = rsqrtf(sk + 1e-6f);
    qk[lane] = make_float2(cv[0] * rq, cv[2] * rk);
    qk[lane + 64] = make_float2(cv[1] * rq, cv[3] * rk);
    const bf16_t* row = proj + g * OD_IN;
    float beta = sigmoidf_(bf2f(row[4608 + dir * 4 + h]));
    float gg = -aexp * softplusf_(bf2f(row[4616 + dir * 4 + h]) + dtb);
    float alpha = expf(gg);
    __syncthreads();
    float kS = 0.f;
#pragma unroll
    for (int d = 0; d < 64; d += 2) {
      float4 t4 = *(const float4*)(qkh + d);
      kS += t4.y * s[d] + t4.w * s[d + 1];
      if ((d & 7) == 6) asm volatile("" ::: "memory");
    }
    kS += __shfl_xor(kS, 32);
    float vn = beta * (cv[4] - alpha * kS);
    float o = 0.f;
#pragma unroll
    for (int d = 0; d < 64; d += 2) {
      float4 t4 = *(const float4*)(qkh + d);
      s[d] = alpha * s[d] + t4.y * vn; o += t4.x * s[d];
      s[d + 1] = alpha * s[d + 1] + t4.w * vn; o += t4.z * s[d + 1];
      if ((d & 7) == 6) asm volatile("" ::: "memory");
    }
    o += __shfl_xor(o, 32);
    if (dh == 0) ob[g * DM + 512 + h * 128 + vs4 * 32 + vl] = f2bf(o);
    __syncthreads();
  }
}

template <int TM, int TN, int K>
__device__ __forceinline__ void lds_mma(const bf16_t* A, int lda, const bf16_t* B, int ldb, int m0, int n0, f32x4 (&acc)[TM][TN], int lane) {
  const int l15 = lane & 15, quad = lane >> 4;
  const bf16_t* ap = A + (m0 + l15) * lda + quad * 8;
  const bf16_t* bp = B + (n0 + l15) * ldb + quad * 8;
#pragma unroll
  for (int k = 0; k < K; k += 32) {
    bf16x8 a[TM], b[TN];
#pragma unroll
    for (int i = 0; i < TM; ++i) a[i] = *(const bf16x8*)(ap + i * 16 * lda + k);
#pragma unroll
    for (int j = 0; j < TN; ++j) b[j] = *(const bf16x8*)(bp + j * 16 * ldb + k);
#pragma unroll
    for (int i = 0; i < TM; ++i)
#pragma unroll
      for (int j = 0; j < TN; ++j) acc[i][j] = __builtin_amdgcn_mfma_f32_16x16x32_bf16(a[i], b[j], acc[i][j], 0, 0, 0);
  }
}
__device__ __forceinline__ void unpack8(uint4 u, float* f) {
  f[0] = __uint_as_float(u.x << 16); f[1] = __uint_as_float(u.x & 0xffff0000u);
  f[2] = __uint_as_float(u.y << 16); f[3] = __uint_as_float(u.y & 0xffff0000u);
  f[4] = __uint_as_float(u.z << 16); f[5] = __uint_as_float(u.z & 0xffff0000u);
  f[6] = __uint_as_float(u.w << 16); f[7] = __uint_as_float(u.w & 0xffff0000u);
}
__device__ __forceinline__ uint4 pack8(const float* f) {
  uint4 u; u.x = pack2(f[0], f[1]); u.y = pack2(f[2], f[3]); u.z = pack2(f[4], f[5]); u.w = pack2(f[6], f[7]); return u;
}

__device__ __forceinline__ void cret(const Params& p, int layer, int item, char* lds) {
  const int tid = otid(), lane = tid & 63, wave = tid >> 6, l15 = lane & 15, quad = lane >> 4;
  const int b = item >> 4, h = (item >> 2) & 3, dir = (item >> 1) & 1, vs = item & 1;
  const int e = layer >> 1;
  const bf16_t* proj = (const bf16_t*)(p.ws + OFF_BIG);
  bf16_t* ob = (bf16_t*)(p.ws + (dir ? OFF_BUFA : OFF_BUFB));
  const float* ct = (const float*)(p.ws + OFF_ROPE); const float* st = ct + 4096 * 32;
  const float lg = p.in[19][(e * 2 + dir) * 4 + h];
  bf16_t* PQ = (bf16_t*)lds;
  bf16_t* Ks = PQ + 128 * 200;
  bf16_t* KT = Ks + 128 * 72;
  bf16_t* VB = KT + 64 * 136;
  bf16_t* V2T = VB + 64 * 200;
  const float cdec = __expf(lg * 128.f);
  f32x4 S[1][2];
  S[0][0] = (f32x4){0.f, 0.f, 0.f, 0.f}; S[0][1] = S[0][0];
  for (int i = tid; i < 64 * 64; i += NTHREADS) VB[(i >> 6) * 200 + 128 + (i & 63)] = 0;
  const int si = tid >> 2, sq = tid & 3;
  const float qd = __expf(lg * (float)(si + 1)), kd = __expf(lg * (float)(127 - si));
  uint4 rr_[6]; float4 rc_[4];
  int rn_ = 0;
#define RET_LOAD(cc) do { rn_ = scan2nat((cc) * 128 + si, dir); const bf16_t* row_ = proj + ((size_t)b * NTB + rn_) * EV_IN; \
    rr_[0] = *(const uint4*)(row_ + 1024 + h * 64 + 8 * sq); rr_[1] = *(const uint4*)(row_ + 1024 + h * 64 + 32 + 8 * sq); \
    rr_[2] = *(const uint4*)(row_ + 1280 + h * 64 + 8 * sq); rr_[3] = *(const uint4*)(row_ + 1280 + h * 64 + 32 + 8 * sq); \
    rr_[4] = *(const uint4*)(row_ + 1536 + h * 128 + vs * 64 + 16 * sq); rr_[5] = *(const uint4*)(row_ + 1536 + h * 128 + vs * 64 + 16 * sq + 8); \
    { const int tt_ = rn_ >= 256 ? rn_ - 256 : 0; const float* cp_ = ct + tt_ * 32 + 8 * sq; const float* sp_ = st + tt_ * 32 + 8 * sq; \
      rc_[0] = *(const float4*)cp_; rc_[1] = *(const float4*)(cp_ + 4); rc_[2] = *(const float4*)sp_; rc_[3] = *(const float4*)(sp_ + 4); } } while (0)
  RET_LOAD(0);
  for (int c = 0; c < 34; ++c) {
    {
      const int n = rn_;
      float q1[8], q2[8], k1[8], k2[8];
      unpack8(rr_[0], q1);
      unpack8(rr_[1], q2);
      unpack8(rr_[2], k1);
      unpack8(rr_[3], k2);
      float vv[16];
      unpack8(rr_[4], vv);
      unpack8(rr_[5], vv + 8);
      float cc[8], ss[8];
      *(float4*)cc = rc_[0]; *(float4*)(cc + 4) = rc_[1];
      *(float4*)ss = rc_[2]; *(float4*)(ss + 4) = rc_[3];
      if (c + 1 < 34) RET_LOAD(c + 1);
      if (n >= 256) {
#pragma unroll
        for (int j = 0; j < 8; ++j) {
          float a1 = q1[j] * cc[j] - q2[j] * ss[j], a2 = q1[j] * ss[j] + q2[j] * cc[j]; q1[j] = a1; q2[j] = a2;
          float b1 = k1[j] * cc[j] - k2[j] * ss[j], b2 = k1[j] * ss[j] + k2[j] * cc[j]; k1[j] = b1; k2[j] = b2;
        }
      }
#pragma unroll
      for (int j = 0; j < 8; ++j) { q1[j] *= qd; q2[j] *= qd; k1[j] *= 0.125f; k2[j] *= 0.125f; }
      *(uint4*)(PQ + si * 200 + 128 + 8 * sq) = pack8(q1);
      *(uint4*)(PQ + si * 200 + 160 + 8 * sq) = pack8(q2);
      *(uint4*)(Ks + si * 72 + 8 * sq) = pack8(k1);
      *(uint4*)(Ks + si * 72 + 32 + 8 * sq) = pack8(k2);
#pragma unroll
      for (int j = 0; j < 8; ++j) { KT[(8 * sq + j) * 136 + si] = f2bf(k1[j]); KT[(32 + 8 * sq + j) * 136 + si] = f2bf(k2[j]); }
#pragma unroll
      for (int j = 0; j < 16; ++j) { VB[(16 * sq + j) * 200 + si] = f2bf(vv[j]); V2T[(16 * sq + j) * 136 + si] = f2bf(vv[j] * kd); }
    }
    __syncthreads();
    {
      const int m0 = wave * 16;
#pragma unroll
      for (int nt = 0; nt < 8; ++nt) {
        f32x4 acc[1][1]; acc[0][0] = (f32x4){0.f, 0.f, 0.f, 0.f};
        if (nt <= wave) lds_mma<1, 1, 64>(PQ + 128, 200, Ks, 72, m0, nt * 16, acc, lane);
        const int j = nt * 16 + l15;
        const float sc = __expf(-lg * (float)(j + 1));
#pragma unroll
        for (int r = 0; r < 4; ++r) {
          const int i = m0 + quad * 4 + r;
          float v = (nt <= wave && i >= j) ? acc[0][0][r] * sc : 0.f;
          PQ[i * 200 + j] = f2bf(v);
        }
      }
    }
    __syncthreads();
    {
      const int m0 = wave * 16;
      f32x4 acc[1][4];
#pragma unroll
      for (int j = 0; j < 4; ++j) acc[0][j] = (f32x4){0.f, 0.f, 0.f, 0.f};
      lds_mma<1, 4, 192>(PQ, 200, VB, 200, m0, 0, acc, lane);
#pragma unroll
      for (int r = 0; r < 4; ++r) {
        const int i = m0 + quad * 4 + r;
        const int n = scan2nat(c * 128 + i, dir);
        bf16_t* orow = ob + ((size_t)b * NTB + n) * DM + 512 + h * 128 + vs * 64 + l15;
#pragma unroll
        for (int j = 0; j < 4; ++j) orow[j * 16] = f2bf(acc[0][j][r]);
      }
    }
    const int sm0 = (wave >> 1) * 16, sn0 = (wave & 1) * 32;
    {
      S[0][0] *= cdec; S[0][1] *= cdec;
      lds_mma<1, 2, 128>(KT, 136, V2T, 136, sm0, sn0, S, lane);
    }
    __syncthreads();
#pragma unroll
    for (int j = 0; j < 2; ++j) {
      const int v = sn0 + j * 16 + l15, d = sm0 + quad * 4;
      uint2 u; u.x = pack2(S[0][j][0], S[0][j][1]); u.y = pack2(S[0][j][2], S[0][j][3]);
      *(uint2*)(VB + v * 200 + 128 + d) = u;
    }
  }
  __syncthreads();
}

__device__ __forceinline__ void clru(const Params& p, int layer, int item, char* lds) {
  const int tid = otid(), lane = tid & 63, wave = tid >> 6, l15 = lane & 15, quad = lane >> 4;
  const int kb = item & 7, dir = (item >> 3) & 1, b = item >> 4;
  const int e = layer >> 1;
  const bf16_t* proj = (const bf16_t*)(p.ws + OFF_BIG);
  bf16_t* ob = (bf16_t*)(p.ws + (dir ? OFF_BUFA : OFF_BUFB));
  bf16_t* Wt = (bf16_t*)lds;
  bf16_t* Ub = Wt + 128 * 72;
  float* Uf = (float*)(Ub + 64 * 72);
  float* LA = Uf + 64 * 64;
  float* IG = LA + 64 * 64;
  {
    const float* wap = p.in[14] + ((size_t)((e * 2 + dir) * 8 + kb) * 64) * 64;
    const float* wxp = p.in[16] + ((size_t)((e * 2 + dir) * 8 + kb) * 64) * 64;
    for (int i = tid; i < 4096; i += NTHREADS) {
      int ii = i >> 6, jj = i & 63;
      Wt[jj * 72 + ii] = f2bf(wap[i]);
      Wt[(64 + jj) * 72 + ii] = f2bf(wxp[i]);
    }
  }
  const int si = tid >> 3, sp = tid & 7;
  float cw[4][8], cb[8];
#pragma unroll
  for (int j = 0; j < 8; ++j) {
    const int ch = kb * 64 + sp * 8 + j;
    cb[j] = p.in[13][e * 512 + ch];
#pragma unroll
    for (int t = 0; t < 4; ++t) cw[t][j] = p.in[12][(e * 4 + t) * 512 + ch];
  }
  float gba[2], gbx[2], gsl[2];
#pragma unroll
  for (int t = 0; t < 2; ++t) {
    const int ch = kb * 64 + (wave & 1) * 32 + t * 16 + l15;
    gba[t] = p.in[15][(e * 2 + dir) * 512 + ch];
    gbx[t] = p.in[17][(e * 2 + dir) * 512 + ch];
    gsl[t] = -8.f * softplusf_(-p.in[18][(e * 2 + dir) * 512 + ch]);
  }
  float hst = 0.f;
  __syncthreads();
  uint4 rx[4];
#define LRU_LOAD(cc) do { const int n_ = scan2nat((cc) * 64 + si, dir); const int lo_ = n_ < 256 ? 0 : 256, hi_ = n_ < 256 ? 256 : NTB; \
    _Pragma("unroll") for (int t = 0; t < 4; ++t) { const int nn = n_ + t - 2; const bool ok = (nn >= lo_ && nn < hi_); \
      const uint4 v_ = *(const uint4*)(proj + ((size_t)b * NTB + (ok ? nn : n_)) * EV_IN + kb * 64 + sp * 8); \
      rx[t] = ok ? v_ : make_uint4(0u, 0u, 0u, 0u); } } while (0)
  LRU_LOAD(0);
  for (int c = 0; c < 68; ++c) {
    {
      float u[8];
#pragma unroll
      for (int j = 0; j < 8; ++j) u[j] = cb[j];
#pragma unroll
      for (int t = 0; t < 4; ++t) {
        float xv[8];
        unpack8(rx[t], xv);
#pragma unroll
        for (int j = 0; j < 8; ++j) u[j] += cw[t][j] * xv[j];
      }
      if (c + 1 < 68) LRU_LOAD(c + 1);
      *(float4*)(Uf + si * 64 + sp * 8) = *(float4*)u;
      *(float4*)(Uf + si * 64 + sp * 8 + 4) = *(float4*)(u + 4);
      *(uint4*)(Ub + si * 72 + sp * 8) = pack8(u);
    }
    __syncthreads();
    {
      const int m0 = (wave >> 1) * 16, n0 = (wave & 1) * 32;
      f32x4 ar[1][2], ai[1][2];
      ar[0][0] = (f32x4){0.f, 0.f, 0.f, 0.f}; ar[0][1] = ar[0][0]; ai[0][0] = ar[0][0]; ai[0][1] = ar[0][0];
      lds_mma<1, 2, 64>(Ub, 72, Wt, 72, m0, n0, ar, lane);
      lds_mma<1, 2, 64>(Ub, 72, Wt, 72, m0, 64 + n0, ai, lane);
#pragma unroll
      for (int t = 0; t < 2; ++t) {
        const int jj = n0 + t * 16 + l15;
#pragma unroll
        for (int r = 0; r < 4; ++r) {
          const int i = m0 + quad * 4 + r;
          const float la = gsl[t] * sigmoidf_(ar[0][t][r] + gba[t]);
          const float ig = sigmoidf_(ai[0][t][r] + gbx[t]);
          const float a = __expf(la);
          LA[i * 64 + jj] = a;
          IG[i * 64 + jj] = __builtin_amdgcn_sqrtf(fmaxf(1.f - a * a, 0.f)) * ig * Uf[i * 64 + jj];
        }
      }
    }
    __syncthreads();
    if (wave == 0) {
#pragma unroll
      for (int bq = 0; bq < 4; ++bq) {
        float av[16], bv[16];
#pragma unroll
        for (int i = 0; i < 16; ++i) { av[i] = LA[(bq * 16 + i) * 64 + lane]; bv[i] = IG[(bq * 16 + i) * 64 + lane]; }
#pragma unroll
        for (int i = 0; i < 16; ++i) { hst = av[i] * hst + bv[i]; Uf[(bq * 16 + i) * 64 + lane] = hst; }
      }
    }
    __syncthreads();
    {
      const int n = scan2nat(c * 64 + si, dir);
      float hv[8];
      *(float4*)hv = *(const float4*)(Uf + si * 64 + sp * 8);
      *(float4*)(hv + 4) = *(const float4*)(Uf + si * 64 + sp * 8 + 4);
      *(uint4*)(ob + ((size_t)b * NTB + n) * DM + kb * 64 + sp * 8) = pack8(hv);
    }
    __syncthreads();
  }
}

__device__ __forceinline__ void cgla(const Params& p, int layer, int item, char* lds) {
  const int tid = otid(), lane = tid & 63, wave = tid >> 6, l15 = lane & 15, quad = lane >> 4;
  const int b = item >> 4, h = (item >> 2) & 3, dir = (item >> 1) & 1, vs = item & 1;
  const int o_ = layer >> 1;
  const bf16_t* proj = (const bf16_t*)(p.ws + OFF_BIG);
  bf16_t* ob = (bf16_t*)(p.ws + (dir ? OFF_BUFA : OFF_BUFB));
  float* AF = (float*)lds;
  bf16_t* PQ = (bf16_t*)(lds + 32768);
  bf16_t* Qt = PQ + 64 * 200;
  bf16_t* Kt = Qt + 64 * 136;
  bf16_t* VB = Kt + 64 * 136;
  bf16_t* K3T = VB + 64 * 200;
  float* LB = (float*)(K3T + 128 * 72);
  if (tid < 128) {
    const int d = h * 128 + tid;
    float l0 = p.in[21][(dir * 2 + 0) * 512 + d], l1 = p.in[21][(dir * 2 + 1) * 512 + d];
    LB[tid] = o_ == 0 ? 0.f : 1.f / (1.f + __expf(l0 - l1));
  }
  for (int i = tid; i < 64 * 128; i += NTHREADS) VB[(i >> 7) * 200 + 64 + (i & 127)] = 0;
  f32x4 S[1][4];
#pragma unroll
  for (int j = 0; j < 4; ++j) S[0][j] = (f32x4){0.f, 0.f, 0.f, 0.f};
  const int si = tid >> 3, sp = tid & 7;
  __syncthreads();
  for (int c = 0; c < 68; ++c) {
    float qr[16], kr[16];
    const int n_s = scan2nat(c * 64 + si, dir);
    const bf16_t* row = proj + ((size_t)b * NTB + n_s) * OD_IN;
    {
      float fp[16];
      unpack8(*(const uint4*)(row + h * 128 + 16 * sp), qr);
      unpack8(*(const uint4*)(row + h * 128 + 16 * sp + 8), qr + 8);
      unpack8(*(const uint4*)(row + (dir ? 1024 : 512) + h * 128 + 16 * sp), fp);
      unpack8(*(const uint4*)(row + (dir ? 1024 : 512) + h * 128 + 16 * sp + 8), fp + 8);
#pragma unroll
      for (int j = 0; j < 16; ++j) {
        const float lb = LB[16 * sp + j];
        const float f = lb + (1.f - lb) * sigmoidf_(fp[j]);
        kr[j] = 1.f - f;
        qr[j] = siluf_(qr[j]);
        AF[si * 128 + 16 * sp + j] = __logf(f);
      }
      float vv[8];
      unpack8(*(const uint4*)(row + 1536 + h * 128 + vs * 64 + 8 * sp), vv);
#pragma unroll
      for (int j = 0; j < 8; ++j) VB[(8 * sp + j) * 200 + si] = f2bf(vv[j]);
    }
    __syncthreads();
    if (tid < 128) {
      float a = 0.f;
#pragma unroll 8
      for (int i = 0; i < 64; ++i) { a += AF[i * 128 + tid]; AF[i * 128 + tid] = a; }
    }
    __syncthreads();
    {
      float t1[16], t2[16], t3[16];
#pragma unroll
      for (int j = 0; j < 16; ++j) {
        const int d = 16 * sp + j;
        const float a = AF[si * 128 + d], rr = AF[31 * 128 + d], al = AF[63 * 128 + d];
        t1[j] = qr[j] * __expf(a - rr);
        t2[j] = kr[j] * __expf(rr - a);
        t3[j] = qr[j] * __expf(a);
        K3T[d * 72 + si] = f2bf(kr[j] * __expf(al - a));
      }
      *(uint4*)(Qt + si * 136 + 16 * sp) = pack8(t1); *(uint4*)(Qt + si * 136 + 16 * sp + 8) = pack8(t1 + 8);
      *(uint4*)(Kt + si * 136 + 16 * sp) = pack8(t2); *(uint4*)(Kt + si * 136 + 16 * sp + 8) = pack8(t2 + 8);
      *(uint4*)(PQ + si * 200 + 64 + 16 * sp) = pack8(t3); *(uint4*)(PQ + si * 200 + 64 + 16 * sp + 8) = pack8(t3 + 8);
    }
    __syncthreads();
    {
      const int m0 = (wave >> 1) * 16, n0 = (wave & 1) * 32;
      f32x4 acc[1][2]; acc[0][0] = (f32x4){0.f, 0.f, 0.f, 0.f}; acc[0][1] = acc[0][0];
      lds_mma<1, 2, 128>(Qt, 136, Kt, 136, m0, n0, acc, lane);
#pragma unroll
      for (int j = 0; j < 2; ++j)
#pragma unroll
        for (int r = 0; r < 4; ++r) {
          const int i = m0 + quad * 4 + r, jj = n0 + j * 16 + l15;
          PQ[i * 200 + jj] = f2bf(i >= jj ? acc[0][j][r] : 0.f);
        }
    }
    __syncthreads();
    {
      const int m0 = (wave >> 1) * 16, n0 = (wave & 1) * 32;
      f32x4 acc[1][2]; acc[0][0] = (f32x4){0.f, 0.f, 0.f, 0.f}; acc[0][1] = acc[0][0];
      lds_mma<1, 2, 192>(PQ, 200, VB, 200, m0, n0, acc, lane);
#pragma unroll
      for (int r = 0; r < 4; ++r) {
        const int i = m0 + quad * 4 + r;
        const int n = scan2nat(c * 64 + i, dir);
        bf16_t* orow = ob + ((size_t)b * NTB + n) * DM + h * 128 + vs * 64 + n0 + l15;
        orow[0] = f2bf(acc[0][0][r]); orow[16] = f2bf(acc[0][1][r]);
      }
    }
    {
      const int m0 = wave * 16;
#pragma unroll
      for (int r = 0; r < 4; ++r) {
        const float dec = __expf(AF[63 * 128 + m0 + quad * 4 + r]);
#pragma unroll
        for (int j = 0; j < 4; ++j) S[0][j][r] *= dec;
      }
      lds_mma<1, 4, 64>(K3T, 72, VB, 200, m0, 0, S, lane);
    }
    __syncthreads();
#pragma unroll
    for (int j = 0; j < 4; ++j) {
      const int v = j * 16 + l15, d = wave * 16 + quad * 4;
      uint2 u; u.x = pack2(S[0][j][0], S[0][j][1]); u.y = pack2(S[0][j][2], S[0][j][3]);
      *(uint2*)(VB + v * 200 + 64 + d) = u;
    }
  }
  __syncthreads();
}

#define OFF_GC   506527744ull
#define OFF_BETA 507641856ull
__device__ __forceinline__ void gdn_prep_phase(const Params& p, int layer, char* lds) {
  const int tid = otid(), lane = tid & 63, wave = tid >> 6, l15 = lane & 15, quad = lane >> 4;
  const int o_ = layer >> 1;
  const bf16_t* proj = (const bf16_t*)(p.ws + OFF_BIG);
  bf16_t* Ks = (bf16_t*)lds;
  float* KK = (float*)(Ks + 64 * 136);
  float* Mf = KK + 64 * 68;
  float* CWA = Mf + 2 * 64 * 68;
  float* sm = CWA + 2048;
  float* gcg = (float*)(p.ws + OFF_GC);
  float* btg = (float*)(p.ws + OFF_BETA);
  const int si = tid >> 3, sp = tid & 7;
  for (int i = tid; i < 2048; i += NTHREADS) {
    const int hh = i >> 9, t = (i >> 7) & 3, d = i & 127;
    CWA[i] = p.in[22][((size_t)o_ * 4 + t) * 1536 + 512 + hh * 128 + d];
  }
  uint4 pk[4][2]; float pgb = 0.f, pga = 0.f;
#define PREP_LOAD(it_) do { const int cn_ = (it_) % 68, h_ = ((it_) / 68) & 3, b_ = (it_) / 272; \
    const int n_ = cn_ * 64 + si; const int lo_ = n_ < 256 ? 0 : 256, hi_ = n_ < 256 ? 256 : NTB; \
    _Pragma("unroll") for (int t = 0; t < 4; ++t) { const int nn = n_ + t - 2; const bool ok = (nn >= lo_ && nn < hi_); \
      const bf16_t* rr = proj + ((size_t)b_ * NTB + (ok ? nn : n_)) * OD_IN + 3072 + h_ * 128 + 16 * sp; \
      const uint4 a_ = *(const uint4*)rr, c_ = *(const uint4*)(rr + 8); \
      pk[t][0] = ok ? a_ : make_uint4(0u, 0u, 0u, 0u); pk[t][1] = ok ? c_ : make_uint4(0u, 0u, 0u, 0u); } \
    if (wave < 2) { const int ng_ = wave ? (cn_ * 64 + 63 - lane) : (cn_ * 64 + lane); \
      const bf16_t* row_ = proj + ((size_t)b_ * NTB + ng_) * OD_IN; \
      pgb = bf2f(row_[4608 + wave * 4 + h_]); pga = bf2f(row_[4616 + wave * 4 + h_]); } } while (0)
  if ((int)blockIdx.x < 8 * 4 * 68) PREP_LOAD((int)blockIdx.x);
  __syncthreads();
  for (int item = blockIdx.x; item < 8 * 4 * 68; item += gridDim.x) {
    const int cn = item % 68, h = (item / 68) & 3, b = item / 272;
    const int n0 = cn * 64;
    {
      float ak[16];
#pragma unroll
      for (int j = 0; j < 16; ++j) ak[j] = 0.f;
#pragma unroll
      for (int t = 0; t < 4; ++t) {
        float x[16];
        unpack8(pk[t][0], x); unpack8(pk[t][1], x + 8);
#pragma unroll
        for (int j = 0; j < 16; ++j) ak[j] += CWA[(h * 4 + t) * 128 + 16 * sp + j] * x[j];
      }
      float sk = 0.f;
#pragma unroll
      for (int j = 0; j < 16; ++j) { ak[j] = siluf_(ak[j]); sk += ak[j] * ak[j]; }
      sk = oct_sum(sk);
      const float rk = rsqrtf(sk + 1e-6f);
#pragma unroll
      for (int j = 0; j < 16; ++j) ak[j] *= rk;
      *(uint4*)(Ks + si * 136 + 16 * sp) = pack8(ak); *(uint4*)(Ks + si * 136 + 16 * sp + 8) = pack8(ak + 8);
    }
    const float gbv = pgb, gav = pga;
    if (item + (int)gridDim.x < 8 * 4 * 68) PREP_LOAD(item + (int)gridDim.x);
    if (wave < 2) {
      const int dir = wave;
      const int n = dir ? (n0 + 63 - lane) : (n0 + lane);
      const float aexp = __expf(p.in[23][(o_ * 2 + dir) * 4 + h]);
      const float dtb = p.in[24][(o_ * 2 + dir) * 4 + h];
      const float beta = sigmoidf_(gbv);
      float v = -aexp * softplusf_(gav + dtb);
#pragma unroll
      for (int off = 1; off < 64; off <<= 1) { float t = __shfl_up(v, off); if (lane >= off) v += t; }
      sm[(dir * 2 + 0) * 64 + lane] = beta;
      sm[(dir * 2 + 1) * 64 + lane] = v;
      const size_t gi = ((size_t)((b * 4 + h) * 2 + dir)) * NTB + n;
      gcg[gi] = v; btg[gi] = beta;
    }
    __syncthreads();
    {
      const int m0 = (wave >> 1) * 16, nn0 = (wave & 1) * 32;
      f32x4 acc[1][2]; acc[0][0] = (f32x4){0.f, 0.f, 0.f, 0.f}; acc[0][1] = acc[0][0];
      lds_mma<1, 2, 128>(Ks, 136, Ks, 136, m0, nn0, acc, lane);
#pragma unroll
      for (int j = 0; j < 2; ++j)
#pragma unroll
        for (int r = 0; r < 4; ++r) KK[(m0 + quad * 4 + r) * 68 + nn0 + j * 16 + l15] = acc[0][j][r];
    }
    __syncthreads();
    for (int idx = tid; idx < 2 * 4096; idx += NTHREADS) {
      const int dir = idx >> 12, is = (idx >> 6) & 63, js = idx & 63;
      const int in_ = dir ? 63 - is : is, jn = dir ? 63 - js : js;
      float val = 0.f;
      if (js < is) val = sm[(dir * 2) * 64 + is] * KK[in_ * 68 + jn] * __expf(sm[(dir * 2 + 1) * 64 + is] - sm[(dir * 2 + 1) * 64 + js]);
      Mf[(dir * 64 + is) * 68 + (js & 3) * 16 + (js >> 2)] = val;
    }
    __syncthreads();
    {
      const int dir = tid >> 8, col = (tid & 255) >> 2, q = tid & 3;
      const float* M = Mf + dir * 64 * 68 + q * 16;
      bf16_t* obp = (bf16_t*)(p.ws + (dir ? OFF_BUFA : OFF_BUFB)) + (size_t)b * NTB * DM + 512 + h * 128 + col;
      float xo[16], mc[16], mn[16];
#pragma unroll
      for (int m = 0; m < 16; ++m) { xo[m] = 0.f; mc[m] = 0.f; mn[m] = 0.f; }
#pragma unroll
      for (int i = 0; i < 64; ++i) {
        if (i < 63) {
#pragma unroll
          for (int m4 = 0; m4 <= (i >> 4); ++m4) *(float4*)(mn + 4 * m4) = *(const float4*)(M + (i + 1) * 68 + 4 * m4);
        }
        float part = 0.f;
        if (i > 0) {
#pragma unroll
          for (int m = 0; m <= ((i - 1) >> 2); ++m) part += mc[m] * xo[m];
        }
        part = quad_sum(part);
        const float xi = ((i == col) ? 1.f : 0.f) - part;
        if ((i & 3) == q) xo[i >> 2] = xi;
        if (q == 0) {
          const int n = dir ? (n0 + 63 - i) : (n0 + i);
          const bf16_t xb = f2bf(xi);
          obp[(size_t)n * DM] = xb; obp[(size_t)n * DM + 64] = xb;
        }
#pragma unroll
        for (int m = 0; m < 16; ++m) mc[m] = mn[m];
      }
    }
    __syncthreads();
  }
}

#undef PREP_LOAD
__device__ __forceinline__ void cgdn(const Params& p, int layer, int item, char* lds) {
  const int tid = otid(), lane = tid & 63, wave = tid >> 6, l15 = lane & 15, quad = lane >> 4;
  const int b = item >> 4, h = (item >> 2) & 3, dir = (item >> 1) & 1, vs = item & 1;
  const int o_ = layer >> 1;
  const bf16_t* proj = (const bf16_t*)(p.ws + OFF_BIG);
  bf16_t* ob = (bf16_t*)(p.ws + (dir ? OFF_BUFA : OFF_BUFB));
  const float* gcg = (const float*)(p.ws + OFF_GC) + ((size_t)((b * 4 + h) * 2 + dir)) * NTB;
  const float* btg = (const float*)(p.ws + OFF_BETA) + ((size_t)((b * 4 + h) * 2 + dir)) * NTB;
  bf16_t* Qs = (bf16_t*)lds;
  bf16_t* Ks = Qs + 64 * 136;
  bf16_t* KT = Ks + 64 * 136;
  bf16_t* Ks2 = KT + 128 * 72;
  bf16_t* Tm = Ks2 + 64 * 136;
  bf16_t* PQ = Tm + 64 * 72;
  bf16_t* VB = PQ + 64 * 200;
  bf16_t* V2T = VB + 64 * 200;
  bf16_t* RT = V2T + 64 * 72;
  float* CW = (float*)(RT + 64 * 72);
  float* gcs = CW + 4 * 320;
  float* e2 = gcs + 64;
  for (int i = tid; i < 4 * 320; i += NTHREADS) {
    const int t = i / 320, cc = i % 320;
    const int ch = cc < 128 ? (h * 128 + cc) : cc < 256 ? (512 + h * 128 + cc - 128) : (1024 + h * 128 + vs * 64 + cc - 256);
    CW[i] = p.in[22][((size_t)o_ * 4 + t) * 1536 + ch];
  }
  for (int i = tid; i < 64 * 128; i += NTHREADS) VB[(i >> 7) * 200 + 64 + (i & 127)] = 0;
  f32x4 S[1][4];
#pragma unroll
  for (int j = 0; j < 4; ++j) S[0][j] = (f32x4){0.f, 0.f, 0.f, 0.f};
  const int si = tid >> 3, sp = tid & 7;
  const int tp = tid >> 4, cg = tid & 15;
  const int m0 = (wave >> 1) * 16, n0 = (wave & 1) * 32;
  uint4 rq[5], rk[5], rtt; uint2 rv[5]; float rg0, rg1, rb0, rb1, rgl;
#define GDN_LOAD(cc) do { \
    const int na_ = scan2nat((cc) * 64 + 2 * tp, dir); \
    const int nlo_ = dir ? na_ - 1 : na_; \
    const int lo_ = nlo_ < 256 ? 0 : 256, hi_ = nlo_ < 256 ? 256 : NTB; \
    const int nb_ = dir ? na_ - 1 : na_ + 1; \
    rg0 = gcg[na_]; rg1 = gcg[nb_]; rb0 = btg[na_]; rb1 = btg[nb_]; rgl = gcg[scan2nat((cc) * 64 + 63, dir)]; \
    rtt = *(const uint4*)(ob + ((size_t)b * NTB + scan2nat((cc) * 64 + si, dir)) * DM + 512 + h * 128 + vs * 64 + 8 * sp); \
    _Pragma("unroll") for (int k = 0; k < 5; ++k) { \
      const int nn = nlo_ - 2 + k; \
      const bool ok = (nn >= lo_ && nn < hi_); \
      const bf16_t* rr = proj + ((size_t)b * NTB + (ok ? nn : nlo_)) * OD_IN; \
      const uint4 a_ = *(const uint4*)(rr + 2560 + h * 128 + 8 * cg); \
      const uint4 b_ = *(const uint4*)(rr + 3072 + h * 128 + 8 * cg); \
      const uint2 c_ = *(const uint2*)(rr + 3584 + h * 128 + vs * 64 + 4 * cg); \
      rq[k] = ok ? a_ : make_uint4(0u, 0u, 0u, 0u); rk[k] = ok ? b_ : make_uint4(0u, 0u, 0u, 0u); rv[k] = ok ? c_ : make_uint2(0u, 0u); } } while (0)
  GDN_LOAD(0);
  __syncthreads();
  for (int c = 0; c < 68; ++c) {
    float gl;
    {
      gl = rgl;
      const float gc0 = rg0, gc1 = rg1, bi0 = rb0, bi1 = rb1;
      *(uint4*)(Tm + si * 72 + 8 * sp) = rtt;
      const int i0 = 2 * tp, i1 = 2 * tp + 1;
      const float eg0 = __expf(gc0), eg1 = __expf(gc1), kb0 = bi0 * eg0, kb1 = bi1 * eg1;
      {
        float aL[8], aH[8];
#pragma unroll
        for (int j = 0; j < 8; ++j) { aL[j] = 0.f; aH[j] = 0.f; }
#pragma unroll
        for (int k = 0; k < 5; ++k) {
          float x[8]; unpack8(rq[k], x);
          if (k < 4) {
#pragma unroll
            for (int j = 0; j < 8; ++j) aL[j] += CW[k * 320 + 8 * cg + j] * x[j];
          }
          if (k > 0) {
#pragma unroll
            for (int j = 0; j < 8; ++j) aH[j] += CW[(k - 1) * 320 + 8 * cg + j] * x[j];
          }
        }
        float sL = 0.f, sH = 0.f;
#pragma unroll
        for (int j = 0; j < 8; ++j) { aL[j] = siluf_(aL[j]); aH[j] = siluf_(aH[j]); sL += aL[j] * aL[j]; sH += aH[j] * aH[j]; }
        sL = row16_sum(sL); sH = row16_sum(sH);
        const float rL = rsqrtf(sL + 1e-6f) * 0.08838834764831845f, rH = rsqrtf(sH + 1e-6f) * 0.08838834764831845f;
        float q0[8], q1[8];
#pragma unroll
        for (int j = 0; j < 8; ++j) { const float a_ = aL[j] * rL, b_ = aH[j] * rH; q0[j] = dir ? b_ : a_; q1[j] = dir ? a_ : b_; }
        *(uint4*)(Qs + i0 * 136 + 8 * cg) = pack8(q0); *(uint4*)(Qs + i1 * 136 + 8 * cg) = pack8(q1);
#pragma unroll
        for (int j = 0; j < 8; ++j) { q0[j] *= eg0; q1[j] *= eg1; }
        *(uint4*)(PQ + i0 * 200 + 64 + 8 * cg) = pack8(q0); *(uint4*)(PQ + i1 * 200 + 64 + 8 * cg) = pack8(q1);
      }
      asm volatile("" ::: "memory");
      {
        float aL[8], aH[8];
#pragma unroll
        for (int j = 0; j < 8; ++j) { aL[j] = 0.f; aH[j] = 0.f; }
#pragma unroll
        for (int k = 0; k < 5; ++k) {
          float x[8]; unpack8(rk[k], x);
          if (k < 4) {
#pragma unroll
            for (int j = 0; j < 8; ++j) aL[j] += CW[k * 320 + 128 + 8 * cg + j] * x[j];
          }
          if (k > 0) {
#pragma unroll
            for (int j = 0; j < 8; ++j) aH[j] += CW[(k - 1) * 320 + 128 + 8 * cg + j] * x[j];
          }
        }
        float sL = 0.f, sH = 0.f;
#pragma unroll
        for (int j = 0; j < 8; ++j) { aL[j] = siluf_(aL[j]); aH[j] = siluf_(aH[j]); sL += aL[j] * aL[j]; sH += aH[j] * aH[j]; }
        sL = row16_sum(sL); sH = row16_sum(sH);
        const float rL = rsqrtf(sL + 1e-6f), rH = rsqrtf(sH + 1e-6f);
        float k0[8], k1[8];
#pragma unroll
        for (int j = 0; j < 8; ++j) { const float a_ = aL[j] * rL, b_ = aH[j] * rH; k0[j] = dir ? b_ : a_; k1[j] = dir ? a_ : b_; }
        *(uint4*)(Ks + i0 * 136 + 8 * cg) = pack8(k0); *(uint4*)(Ks + i1 * 136 + 8 * cg) = pack8(k1);
#pragma unroll
        for (int j = 0; j < 8; ++j) *(unsigned*)(KT + (8 * cg + j) * 72 + i0) = pack2(k0[j], k1[j]);
#pragma unroll
        for (int j = 0; j < 8; ++j) { k0[j] *= kb0; k1[j] *= kb1; }
        *(uint4*)(Ks2 + i0 * 136 + 8 * cg) = pack8(k0); *(uint4*)(Ks2 + i1 * 136 + 8 * cg) = pack8(k1);
      }
      asm volatile("" ::: "memory");
      {
        float aL[4], aH[4];
#pragma unroll
        for (int j = 0; j < 4; ++j) { aL[j] = 0.f; aH[j] = 0.f; }
#pragma unroll
        for (int k = 0; k < 5; ++k) {
          float x[4];
          x[0] = __uint_as_float(rv[k].x << 16); x[1] = __uint_as_float(rv[k].x & 0xffff0000u);
          x[2] = __uint_as_float(rv[k].y << 16); x[3] = __uint_as_float(rv[k].y & 0xffff0000u);
          if (k < 4) {
#pragma unroll
            for (int j = 0; j < 4; ++j) aL[j] += CW[k * 320 + 256 + 4 * cg + j] * x[j];
          }
          if (k > 0) {
#pragma unroll
            for (int j = 0; j < 4; ++j) aH[j] += CW[(k - 1) * 320 + 256 + 4 * cg + j] * x[j];
          }
        }
#pragma unroll
        for (int j = 0; j < 4; ++j) {
          const float a_ = siluf_(aL[j]), b_ = siluf_(aH[j]);
          *(unsigned*)(VB + (4 * cg + j) * 200 + i0) = pack2((dir ? b_ : a_) * bi0, (dir ? a_ : b_) * bi1);
        }
      }
      asm volatile("" ::: "memory");
      if (c + 1 < 68) GDN_LOAD(c + 1);
      if (cg == 0) { gcs[i0] = gc0; gcs[i1] = gc1; e2[i0] = __expf(gl - gc0); e2[i1] = __expf(gl - gc1); }
    }
    __syncthreads();
    {
      f32x4 a2[1][2];
      a2[0][0] = (f32x4){0.f, 0.f, 0.f, 0.f}; a2[0][1] = a2[0][0];
      lds_mma<1, 2, 128>(Qs, 136, Ks, 136, m0, n0, a2, lane);
#pragma unroll
      for (int j = 0; j < 2; ++j)
#pragma unroll
        for (int r = 0; r < 4; ++r) {
          const int i = m0 + quad * 4 + r, jj = n0 + j * 16 + l15;
          PQ[i * 200 + jj] = f2bf((i >= jj) ? a2[0][j][r] * __expf(gcs[i] - gcs[jj]) : 0.f);
        }
      f32x4 pa[1][2];
      pa[0][0] = (f32x4){0.f, 0.f, 0.f, 0.f}; pa[0][1] = pa[0][0];
      lds_mma<1, 2, 128>(Ks2, 136, VB + 64, 200, m0, n0, pa, lane);
#pragma unroll
      for (int j = 0; j < 2; ++j) {
        const int v = n0 + j * 16 + l15, j0 = m0 + quad * 4;
        const uint2 vb = *(const uint2*)(VB + v * 200 + j0);
        const float v0 = __uint_as_float(vb.x << 16), v1 = __uint_as_float(vb.x & 0xffff0000u);
        const float v2 = __uint_as_float(vb.y << 16), v3 = __uint_as_float(vb.y & 0xffff0000u);
        uint2 o; o.x = pack2(v0 - pa[0][j][0], v1 - pa[0][j][1]); o.y = pack2(v2 - pa[0][j][2], v3 - pa[0][j][3]);
        *(uint2*)(RT + v * 72 + j0) = o;
      }
    }
    __syncthreads();
    {
      f32x4 acc[1][2]; acc[0][0] = (f32x4){0.f, 0.f, 0.f, 0.f}; acc[0][1] = acc[0][0];
      lds_mma<1, 2, 64>(Tm, 72, RT, 72, m0, n0, acc, lane);
#pragma unroll
      for (int j = 0; j < 2; ++j) {
        const int v = n0 + j * 16 + l15, i0 = m0 + quad * 4;
        uint2 o; o.x = pack2(acc[0][j][0], acc[0][j][1]); o.y = pack2(acc[0][j][2], acc[0][j][3]);
        *(uint2*)(VB + v * 200 + i0) = o;
        uint2 o2; o2.x = pack2(acc[0][j][0] * e2[i0], acc[0][j][1] * e2[i0 + 1]); o2.y = pack2(acc[0][j][2] * e2[i0 + 2], acc[0][j][3] * e2[i0 + 3]);
        *(uint2*)(V2T + v * 72 + i0) = o2;
      }
    }
    __syncthreads();
    {
      f32x4 acc[1][2]; acc[0][0] = (f32x4){0.f, 0.f, 0.f, 0.f}; acc[0][1] = acc[0][0];
      lds_mma<1, 2, 192>(PQ, 200, VB, 200, m0, n0, acc, lane);
#pragma unroll
      for (int r = 0; r < 4; ++r) {
        const int i = m0 + quad * 4 + r;
        const int n = scan2nat(c * 64 + i, dir);
        bf16_t* orow = ob + ((size_t)b * NTB + n) * DM + 512 + h * 128 + vs * 64 + n0 + l15;
        orow[0] = f2bf(acc[0][0][r]); orow[16] = f2bf(acc[0][1][r]);
      }
    }
    {
      const float ge = __expf(gl);
#pragma unroll
      for (int j = 0; j < 4; ++j) S[0][j] *= ge;
      lds_mma<1, 4, 64>(KT, 72, V2T, 72, wave * 16, 0, S, lane);
    }
    __syncthreads();
#pragma unroll
    for (int j = 0; j < 4; ++j) {
      const int v = j * 16 + l15, d = wave * 16 + quad * 4;
      uint2 uu; uu.x = pack2(S[0][j][0], S[0][j][1]); uu.y = pack2(S[0][j][2], S[0][j][3]);
      *(uint2*)(VB + v * 200 + 64 + d) = uu;
    }
  }
  __syncthreads();
}

#ifndef NAIVE_EVEN
#define NAIVE_EVEN 0
#endif
#ifndef NAIVE_ODD
#define NAIVE_ODD 0
#endif
__device__ __forceinline__ void chains_phase(const Params& p, int layer, char* lds) {
  const int wave = threadIdx.x >> 6;
  float* wl = (float*)(lds + wave * 2048);
  const int item = blockIdx.x + gridDim.x * wave;
  if (layer & 1) {
#if NAIVE_ODD
    if (item >= 512) { chain_idle(); return; }
    if (item < 256) chain_gla(p, layer, item, wl); else chain_gdn(p, layer, item - 256, wl);
#else
    for (int it = blockIdx.x; it < 256; it += gridDim.x) {
      if (it < 128) cgla(p, layer, it, lds); else cgdn(p, layer, it - 128, lds);
    }
#endif
  } else {
#if NAIVE_EVEN
    if (item >= 384) { chain_idle(); return; }
    if (item < 128) chain_ret(p, layer, item, wl); else chain_lru(p, layer, item - 128, wl);
#else
    for (int it = blockIdx.x; it < 256; it += gridDim.x) {
      if (it < 128) cret(p, layer, it, lds); else clru(p, layer, it - 128, lds);
    }
#endif
  }
}

__device__ __forceinline__ void combine_phase(const Params& p, int layer) {
  const int tid = otid(), lane = tid & 63, wave = __builtin_amdgcn_readfirstlane(tid >> 6);
  const int odd = layer & 1;
  const bf16_t* proj = (const bf16_t*)(p.ws + OFF_BIG);
  bf16_t* zf = (bf16_t*)(p.ws + OFF_BUFB);
  const bf16_t* zr = (const bf16_t*)(p.ws + OFF_BUFA);
  const int ldp = odd ? OD_IN : EV_IN;
#pragma unroll 1
  for (int u = blockIdx.x * 8 + wave; u < TT * 2; u += gridDim.x * 8) {
    const int g = u >> 1, hh = u & 1;
    const int c = hh * 512 + lane * 8;
    int gcol;
    if (!odd) gcol = hh ? (2048 + (c - 512)) : (512 + c);
    else gcol = hh ? (4096 + (c - 512)) : (2048 + c);
    const uint4 a4 = *(const uint4*)(zf + (size_t)g * DM + c);
    const uint4 b4 = *(const uint4*)(zr + (size_t)g * DM + c);
    const uint4 g4 = *(const uint4*)(proj + (size_t)g * ldp + gcol);
    float o[8], gt[8], y[8];
    unpack8(a4, o); unpack8(b4, y); unpack8(g4, gt);
#pragma unroll
    for (int j = 0; j < 8; ++j) o[j] += y[j];
    if (!odd && hh == 0) {
#pragma unroll
      for (int j = 0; j < 8; ++j) y[j] = o[j] * gelu_tanh(gt[j]);
    } else {
      if (!odd) {
        float s = 0.f;
#pragma unroll
        for (int j = 0; j < 8; ++j) s += o[j];
        s = row16_sum(s);
        const float mean = s * (1.f / 128.f);
#pragma unroll
        for (int j = 0; j < 8; ++j) o[j] -= mean;
      }
      float ss = 0.f;
#pragma unroll
      for (int j = 0; j < 8; ++j) ss += o[j] * o[j];
      ss = row16_sum(ss);
      const float rs = rsqrtf(ss * (1.f / 128.f) + 1e-6f);
#pragma unroll
      for (int j = 0; j < 8; ++j) y[j] = o[j] * rs * siluf_(gt[j]);
    }
    *(uint4*)(zf + (size_t)g * DM + c) = pack8(y);
  }
}

#define XB_TMO      128
#define XB_XCNT(j)  (256  + 64 * (j))
#define XB_XSUB(j)  (1280 + 64 * (j))
#define XB_XGEN(j)  (2304 + 64 * (j))
#define XB_TOP      3328
#define XB_TOPGEN   3392
#define XCD_BAR_WORDS 3456
#define XB_SPIN_CAP (1u << 18)
#define LAS __attribute__((address_space(3)))
#define OFF_BAR 508755968ull
__device__ __forceinline__ unsigned xb_ld(unsigned* p)              { return __hip_atomic_load(p, __ATOMIC_RELAXED, __HIP_MEMORY_SCOPE_AGENT); }
__device__ __forceinline__ unsigned xb_add(unsigned* p, unsigned v) { return __hip_atomic_fetch_add(p, v, __ATOMIC_RELAXED, __HIP_MEMORY_SCOPE_AGENT); }
__device__ __forceinline__ unsigned xb_xcc_id() { return (unsigned)__builtin_amdgcn_s_getreg((3 << 11) | 20) & 0xFu; }
#define XB_SPIN(cond, bar) do { unsigned _sp = 0; while (cond) { __builtin_amdgcn_s_sleep(1); \
    if ((++_sp & 255u) == 0u) { if (xb_ld(&(bar)[XB_TMO])) break; if (_sp > XB_SPIN_CAP) { atomicAdd(&(bar)[XB_TMO], 1u); break; } } } } while (0)
struct XcdBarrier { unsigned* bar; unsigned x; volatile LAS unsigned* st; };
__device__ __forceinline__ XcdBarrier xcd_barrier_post(unsigned* bar, volatile LAS unsigned* st) {
  XcdBarrier b; b.bar = bar; b.x = xb_xcc_id(); b.st = st;
  if (threadIdx.x == 0) (void)xb_add(&bar[XB_XCNT(b.x)], 1u);
  return b;
}
__device__ __forceinline__ void xcd_barrier_complete(unsigned* bar, unsigned x, unsigned& nloc, unsigned& nx) {
  const unsigned G = gridDim.x * gridDim.y * gridDim.z;
  unsigned sum, cnt, mine, sp = 0u;
  for (;;) {
    sum = 0u; cnt = 0u; mine = 0u;
#pragma unroll
    for (unsigned j = 0; j < 16; ++j) { const unsigned c = xb_ld(&bar[XB_XCNT(j)]); sum += c; cnt += (c > 0u) ? 1u : 0u; mine = (j == x) ? c : mine; }
    if (sum == G) break;
    __builtin_amdgcn_s_sleep(1);
    if ((++sp & 255u) == 0u) { if (xb_ld(&bar[XB_TMO])) break; if (sp > XB_SPIN_CAP) { atomicAdd(&bar[XB_TMO], 1u); break; } }
  }
  nloc = mine > 0u ? mine : 1u; nx = cnt > 0u ? cnt : 1u;
}
__device__ __forceinline__ void xcd_barrier_(const XcdBarrier& b) {
  asm volatile("s_waitcnt vmcnt(0)" ::: "memory");
  __syncthreads();
  if (threadIdx.x == 0) {
    unsigned* bar = b.bar;
    __builtin_amdgcn_s_waitcnt(0);
    unsigned nloc = b.st[0], nx = b.st[1];
    if (nloc == 0u) { xcd_barrier_complete(bar, b.x, nloc, nx); b.st[0] = nloc; b.st[1] = nx; }
    const unsigned old = xb_add(&bar[XB_XSUB(b.x)], 1u);
    const unsigned gen = old / nloc;
    if (old + 1u == (gen + 1u) * nloc) {
      __builtin_amdgcn_fence(__ATOMIC_RELEASE, "agent");
      asm volatile("s_waitcnt vmcnt(0)" ::: "memory");
      const unsigned og = xb_add(&bar[XB_TOP], 1u);
      const unsigned tg = og / nx;
      if (og + 1u == (tg + 1u) * nx) xb_add(&bar[XB_TOPGEN], 1u);
      else XB_SPIN(xb_ld(&bar[XB_TOPGEN]) == tg, bar);
      __builtin_amdgcn_fence(__ATOMIC_ACQUIRE, "agent");
      xb_add(&bar[XB_XGEN(b.x)], 1u);
      asm volatile("s_waitcnt vmcnt(0)" ::: "memory");
    } else {
      XB_SPIN(xb_ld(&bar[XB_XGEN(b.x)]) == gen, bar);
      __builtin_amdgcn_fence(__ATOMIC_ACQUIRE, "agent");
      asm volatile("s_waitcnt vmcnt(0)" ::: "memory");
    }
  }
  __syncthreads();
}

__device__ __forceinline__ void xcd_barrier(const Params& p, char* lds) {
  XcdBarrier b; b.bar = (unsigned*)(p.ws + OFF_BAR); b.x = xb_xcc_id(); b.st = (volatile LAS unsigned*)(LAS char*)(lds + LDS_BYTES - 16);
  xcd_barrier_(b);
}

__global__ void __launch_bounds__(NTHREADS) mega(Params p) {
  extern __shared__ __attribute__((aligned(16))) char lds[];
  cg::grid_group grid = cg::this_grid();
  volatile LAS unsigned* xst = (volatile LAS unsigned*)(LAS char*)(lds + LDS_BYTES - 16);
  if (threadIdx.x == 0) { xst[0] = 0u; xst[1] = 0u; }
  __syncthreads();
  (void)xcd_barrier_post((unsigned*)(p.ws + OFF_BAR), xst);
  phase0(p, lds);
  grid.sync();
  bf16_t* bufA = (bf16_t*)(p.ws + OFF_BUFA);
  bf16_t* bufB = (bf16_t*)(p.ws + OFF_BUFB);
  bf16_t* big = (bf16_t*)(p.ws + OFF_BIG);
  bf16_t* wb = (bf16_t*)(p.ws + OFF_W);
  for (int layer = 0; layer < 4; ++layer) {
    const float* mod = (const float*)(p.ws + OFF_MOD) + (size_t)layer * 9 * 6144;
    const int nin = (layer & 1) ? OD_IN : EV_IN;
    norm_phase(p, layer, 0);
    convert_weights(p, layer, lds);
    xcd_barrier(p, lds);
    gemm_phase<0>(p, bufA, DM, wb + WO_IN, nin, 1024, big, nin, nullptr, lds);
    xcd_barrier(p, lds);
    if (layer & 1) { gdn_prep_phase(p, layer, lds); xcd_barrier(p, lds); }
    chains_phase(p, layer, lds);
    xcd_barrier(p, lds);
    combine_phase(p, layer);
    xcd_barrier(p, lds);
    gemm_phase<2>(p, bufB, DM, wb + WO_OUT, 1024, 1024, nullptr, 0, mod + 2 * 1024, lds, layer == 0);
    xcd_barrier(p, lds);
    norm_phase(p, layer, 1);
    xcd_barrier(p, lds);
    gemm_phase<1>(p, bufA, DM, wb + WO_W1, DFF, 1024, big, DFF, nullptr, lds);
    xcd_barrier(p, lds);
    gemm_phase<2>(p, big, DFF, wb + WO_W2, 1024, 4096, nullptr, 0, mod + 5 * 1024, lds);
    xcd_barrier(p, lds);
  }
  final_norm(p);
}

extern "C" void kernel_launch(void* const* d_in, const int* in_sizes, int n_in, void* d_out, int out_size, void* d_ws, size_t ws_size,
                              hipStream_t stream) {
  static int grid_blocks = 0;
  if (!grid_blocks) {
    int dev = 0, cus = 0, per_cu = 0;
    hipGetDevice(&dev);
    hipDeviceGetAttribute(&cus, hipDeviceAttributeMultiprocessorCount, dev);
    hipFuncSetAttribute((const void*)mega, hipFuncAttributeMaxDynamicSharedMemorySize, LDS_BYTES);
    hipOccupancyMaxActiveBlocksPerMultiprocessor(&per_cu, (const void*)mega, NTHREADS, LDS_BYTES);
    if (per_cu < 1) per_cu = 1;
    if (per_cu > 1) per_cu = 1;
    if (cus < 1) cus = 256;
    grid_blocks = cus * per_cu;
  }
  Params p{};
  for (int i = 0; i < 26; ++i) p.in[i] = (const float*)d_in[i];
  p.out = (float*)d_out;
  p.ws = (unsigned char*)d_ws;
  (void)hipMemsetAsync((char*)d_ws + OFF_BAR, 0, XCD_BAR_WORDS * 4, stream);
  void* args[] = {&p};
  hipError_t e = hipLaunchCooperativeKernel((const void*)mega, dim3(grid_blocks), dim3(NTHREADS), args, LDS_BYTES, stream);
  if (e != hipSuccess) fprintf(stderr, "cooperative launch failed: %s (grid %d)\n", hipGetErrorString(e), grid_blocks);
}
```

```cpp
#include <hip/hip_runtime.h>
#include <hip/hip_cooperative_groups.h>
#include <cstdio>
namespace cg = cooperative_groups;

typedef unsigned short bf16_t;
using bf16x8 = __attribute__((ext_vector_type(8))) short;
using f32x4 = __attribute__((ext_vector_type(4))) float;

#define NTB 4352
#define TT 34816
#define DM 1024
#define DFF 4096
#define EV_IN 2560
#define OD_IN 4624
#define NTHREADS 512
#define LDS_BYTES 157696

#define OFF_XC   0ull
#define OFF_MOD  8388608ull
#define OFF_ROPE 9437184ull
#define OFF_W    10485760ull
#define OFF_BUFA 41943040ull
#define OFF_BUFB 113246208ull
#define OFF_BIG  184549376ull
#define WO_IN   0
#define WO_OUT  4849664
#define WO_W1   5898240
#define WO_W2   10092544

struct Params {
  const float* in[26];
  float* out;
  unsigned char* ws;
};

__device__ __forceinline__ float bf2f(bf16_t u) { return __uint_as_float(((unsigned)u) << 16); }
typedef __bf16 bf16x2_t __attribute__((ext_vector_type(2)));
__device__ __forceinline__ bf16_t f2bf(float f) { return __builtin_bit_cast(unsigned short, (__bf16)f); }
__device__ __forceinline__ unsigned pack2(float a, float b) { bf16x2_t v = {(__bf16)a, (__bf16)b}; return __builtin_bit_cast(unsigned, v); }
__device__ __forceinline__ float frcp_(float x) { return __builtin_amdgcn_rcpf(x); }
__device__ __forceinline__ float sigmoidf_(float x) { return frcp_(1.f + __expf(-x)); }
__device__ __forceinline__ float siluf_(float x) { return x * sigmoidf_(x); }
__device__ __forceinline__ float gelu_tanh(float x) {
  const float u = 0.7978845608028654f * (x + 0.044715f * x * x * x);
  const float t = 1.f - 2.f * frcp_(1.f + __expf(2.f * u));
  return 0.5f * x * (1.f + t);
}
__device__ __forceinline__ float softplusf_(float x) { return fmaxf(x, 0.f) + __logf(1.f + __expf(-fabsf(x))); }
template <int CTRL> __device__ __forceinline__ float dppf(float v) {
  return __int_as_float(__builtin_amdgcn_update_dpp(0, __float_as_int(v), CTRL, 0xF, 0xF, true));
}
__device__ __forceinline__ float quad_sum(float v) { v += dppf<0xB1>(v); v += dppf<0x4E>(v); return v; }
__device__ __forceinline__ float oct_sum(float v) { v = quad_sum(v); v += dppf<0x141>(v); return v; }
__device__ __forceinline__ float row16_sum(float v) { v = oct_sum(v); v += dppf<0x140>(v); return v; }
__device__ __forceinline__ float wave_sum(float v) {
  v = row16_sum(v);
  return __builtin_amdgcn_readlane(v, 0) + __builtin_amdgcn_readlane(v, 16) + __builtin_amdgcn_readlane(v, 32) + __builtin_amdgcn_readlane(v, 48);
}
__device__ __forceinline__ int otid() { int t = threadIdx.x; asm volatile("" : "+v"(t)); return t; }
__device__ __forceinline__ float* xrow(const Params& p, int g) {
  int b = g / NTB, n = g - b * NTB;
  return n < 256 ? ((float*)(p.ws + OFF_XC) + (size_t)(b * 256 + n) * DM) : (p.out + (size_t)(b * 4096 + (n - 256)) * DM);
}
__device__ __forceinline__ const float* xrow_src(const Params& p, int g, bool first) {
  int b = g / NTB, n = g - b * NTB;
  if (first) return n < 256 ? (p.in[2] + (size_t)(b * 256 + n) * DM) : (p.in[0] + (size_t)(b * 4096 + (n - 256)) * DM);
  return n < 256 ? ((const float*)(p.ws + OFF_XC) + (size_t)(b * 256 + n) * DM) : (p.out + (size_t)(b * 4096 + (n - 256)) * DM);
}
__device__ __forceinline__ int scan2nat(int pos, int dir) { return dir ? (pos < 256 ? 255 - pos : 4607 - pos) : pos; }

__device__ __forceinline__ void phase0(const Params& p, char* lds) {
  const int tid = threadIdx.x, lane = tid & 63, wave = tid >> 6;
  float* sv = (float*)lds;
  float* red = (float*)(lds + 36864);
  const float* c = p.in[1];
  const float* cctx = p.in[3];
  for (int i = tid; i < 9 * 1024; i += NTHREADS) {
    float v = (i < 8192) ? c[i] : cctx[i - 8192];
    sv[i] = siluf_(v);
  }
  __syncthreads();
  float* mod = (float*)(p.ws + OFF_MOD);
  for (int it = blockIdx.x; it < 4 * 96; it += gridDim.x) {
    int l = it / 96, cg_ = it % 96;
    int col = cg_ * 64 + lane;
    const float* W = p.in[4] + (size_t)l * 1024 * 6144 + col;
    float acc[9];
#pragma unroll
    for (int r = 0; r < 9; ++r) acc[r] = 0.f;
#pragma unroll 8
    for (int k = wave * 128; k < wave * 128 + 128; ++k) {
      float w = W[(size_t)k * 6144];
#pragma unroll
      for (int r = 0; r < 9; ++r) acc[r] += sv[r * 1024 + k] * w;
    }
#pragma unroll
    for (int r = 0; r < 9; ++r) red[(wave * 9 + r) * 64 + lane] = acc[r];
    __syncthreads();
    for (int i = tid; i < 9 * 64; i += NTHREADS) {
      int r = i / 64, cc = i % 64;
      float s = 0.f;
#pragma unroll
      for (int w = 0; w < 8; ++w) s += red[(w * 9 + r) * 64 + cc];
      int colo = cg_ * 64 + cc;
      mod[((size_t)l * 9 + r) * 6144 + colo] = s + p.in[5][l * 6144 + colo];
    }
    __syncthreads();
  }
  const size_t gt = (size_t)blockIdx.x * NTHREADS + tid, gs = (size_t)gridDim.x * NTHREADS;
  float* ct = (float*)(p.ws + OFF_ROPE); float* st = ct + 4096 * 32;
  for (size_t i = gt; i < 4096 * 32; i += gs) {
    int t = (int)(i >> 5), pp = (int)(i & 31);
    int f = pp & 15;
    float inv = powf(10000.f, -(float)f / 16.f);
    float pos = (pp < 16) ? (float)(t >> 6) : (float)(t & 63);
    float ang = pos * inv;
    ct[i] = cosf(ang); st[i] = sinf(ang);
  }
}

__device__ __forceinline__ void norm_phase(const Params& p, int layer, int which) {
  const int tid = otid(), lane = tid & 63, wave = tid >> 6;
  const float* g = (which ? p.in[7] : p.in[6]) + layer * DM;
  const float* mod = (const float*)(p.ws + OFF_MOD) + (size_t)layer * 9 * 6144;
  bf16_t* dst = (bf16_t*)(p.ws + OFF_BUFA);
  for (int row = blockIdx.x * 8 + wave; row < TT; row += gridDim.x * 8) {
    int b = row / NTB, n = row - b * NTB;
    int r = n < 256 ? 8 : b;
    const float* x = xrow_src(p, row, layer == 0 && which == 0);
    const float* sh = mod + (size_t)r * 6144 + (which ? 3 : 0) * 1024;
    const float* sc = sh + 1024;
    float4 v[4]; float ss = 0.f;
#pragma unroll
    for (int i = 0; i < 4; ++i) { v[i] = *(const float4*)(x + i * 256 + lane * 4); ss += v[i].x * v[i].x + v[i].y * v[i].y + v[i].z * v[i].z + v[i].w * v[i].w; }
    ss = wave_sum(ss);
    float rstd = rsqrtf(ss * (1.f / 1024.f) + 1e-6f);
#pragma unroll
    for (int i = 0; i < 4; ++i) {
      int cidx = i * 256 + lane * 4;
      float4 gg = *(const float4*)(g + cidx), s1 = *(const float4*)(sc + cidx), s0 = *(const float4*)(sh + cidx);
      float a0 = v[i].x * rstd * gg.x * (1.f + s1.x) + s0.x;
      float a1 = v[i].y * rstd * gg.y * (1.f + s1.y) + s0.y;
      float a2 = v[i].z * rstd * gg.z * (1.f + s1.z) + s0.z;
      float a3 = v[i].w * rstd * gg.w * (1.f + s1.w) + s0.w;
      uint2 o; o.x = pack2(a0, a1); o.y = pack2(a2, a3);
      *(uint2*)(dst + (size_t)row * DM + cidx) = o;
    }
  }
}

__device__ __forceinline__ void final_norm(const Params& p) {
  const int tid = otid(), lane = tid & 63, wave = tid >> 6;
  const float* g = p.in[25];
  for (int row = blockIdx.x * 8 + wave; row < 8 * 4096; row += gridDim.x * 8) {
    float* x = p.out + (size_t)row * DM;
    float4 v[4]; float ss = 0.f;
#pragma unroll
    for (int i = 0; i < 4; ++i) { v[i] = *(const float4*)(x + i * 256 + lane * 4); ss += v[i].x * v[i].x + v[i].y * v[i].y + v[i].z * v[i].z + v[i].w * v[i].w; }
    ss = wave_sum(ss);
    float rstd = rsqrtf(ss * (1.f / 1024.f) + 1e-6f);
#pragma unroll
    for (int i = 0; i < 4; ++i) {
      int cidx = i * 256 + lane * 4;
      float4 gg = *(const float4*)(g + cidx);
      float4 o; o.x = v[i].x * rstd * gg.x; o.y = v[i].y * rstd * gg.y; o.z = v[i].z * rstd * gg.z; o.w = v[i].w * rstd * gg.w;
      *(float4*)(x + cidx) = o;
    }
  }
}

__device__ __forceinline__ void convert_weights(const Params& p, int layer, char* lds) {
  const int tid = otid();
  bf16_t* Tl = (bf16_t*)lds;
  bf16_t* wbase = (bf16_t*)(p.ws + OFF_W);
  const int odd = layer & 1;
  const float* srcs[4]; int Ks[4], Ns[4]; bf16_t* dsts[4]; int cnt[4];
  srcs[0] = odd ? p.in[20] + (size_t)(layer >> 1) * 1024 * OD_IN : p.in[11] + (size_t)(layer >> 1) * 1024 * EV_IN;
  Ks[0] = 1024; Ns[0] = odd ? OD_IN : EV_IN; dsts[0] = wbase + WO_IN;
  srcs[1] = p.in[8] + (size_t)layer * 1024 * 1024; Ks[1] = 1024; Ns[1] = 1024; dsts[1] = wbase + WO_OUT;
  srcs[2] = p.in[9] + (size_t)layer * 1024 * 4096; Ks[2] = 1024; Ns[2] = 4096; dsts[2] = wbase + WO_W1;
  srcs[3] = p.in[10] + (size_t)layer * 4096 * 1024; Ks[3] = 4096; Ns[3] = 1024; dsts[3] = wbase + WO_W2;
  int total = 0;
#pragma unroll
  for (int i = 0; i < 4; ++i) { cnt[i] = (Ks[i] / 64) * ((Ns[i] + 63) / 64); total += cnt[i]; }
  for (int it = blockIdx.x; it < total; it += gridDim.x) {
    int r = it, mi = 0;
    if (r >= cnt[0]) { r -= cnt[0]; mi = 1; if (r >= cnt[1]) { r -= cnt[1]; mi = 2; if (r >= cnt[2]) { r -= cnt[2]; mi = 3; } } }
    const float* W = mi == 0 ? srcs[0] : mi == 1 ? srcs[1] : mi == 2 ? srcs[2] : srcs[3];
    const int K = mi == 3 ? 4096 : 1024;
    const int N = mi == 0 ? Ns[0] : mi == 1 ? 1024 : mi == 2 ? 4096 : 1024;
    bf16_t* D = mi == 0 ? dsts[0] : mi == 1 ? dsts[1] : mi == 2 ? dsts[2] : dsts[3];
    const int ntn = (N + 63) / 64;
    const int kt = r / ntn, nt = r % ntn;
    const int k0 = kt * 64, n0 = nt * 64;
    {
      const int rr = tid >> 4, c4 = (tid & 15) * 4;
#pragma unroll
      for (int ps = 0; ps < 2; ++ps) {
        int k = k0 + rr + 32 * ps, n = n0 + c4;
        float4 v = make_float4(0.f, 0.f, 0.f, 0.f);
        if (n < N) v = *(const float4*)(W + (size_t)k * N + n);
        Tl[(c4 + 0) * 72 + rr + 32 * ps] = f2bf(v.x);
        Tl[(c4 + 1) * 72 + rr + 32 * ps] = f2bf(v.y);
        Tl[(c4 + 2) * 72 + rr + 32 * ps] = f2bf(v.z);
        Tl[(c4 + 3) * 72 + rr + 32 * ps] = f2bf(v.w);
      }
    }
    __syncthreads();
    {
      const int nr = tid >> 3, kc = tid & 7;
      if (n0 + nr < N) *(uint4*)(D + (size_t)(n0 + nr) * K + k0 + kc * 8) = *(const uint4*)(Tl + nr * 72 + kc * 8);
    }
    __syncthreads();
  }
}

template <int KS> __device__ __forceinline__ int lds_byte(int r, int c) {
  int st = (r >> 4) * KS + (c >> 5), ob = (r & 15) * 64 + (c & 31) * 2;
  return st * 1024 + (ob ^ (((ob >> 9) & 1) << 5));
}
template <int KS> __device__ __forceinline__ void stage_rc(int b, int& R, int& C) {
  int st = b >> 10, sb = b & 1023, swz = sb ^ (((sb >> 9) & 1) << 5);
  R = (st / KS) * 16 + swz / 64;
  C = (st % KS) * 32 + (swz % 64) / 2;
}
#define WAIT_V0() asm volatile("s_waitcnt vmcnt(0)" ::: "memory")

template <int EPI>
__device__ __forceinline__ void gemm_phase(const Params& p, const bf16_t* __restrict__ A, int lda_unused, const bf16_t* __restrict__ Bt, int N, int K,
                           bf16_t* outb, int ldo, const float* modv, char* lds, bool first = false) {
  constexpr int KS = 2, BK = 64, TA_B = 272 * BK * 2, TB_B = 256 * BK * 2, STAGE_B = TA_B + TB_B, NPASS = 9;
  const int tid = otid(), lane = tid & 63, wid = __builtin_amdgcn_readfirstlane(tid >> 6);
  const int fr = lane & 15, fq = lane >> 4;
  const int wr = wid >> 2, wc = wid & 3, rbase = wr * 144;
  const int nM = TT / 272, nN = (N + 255) / 256, nwg = nM * nN;
  const int nt = K / BK;
  int sR[NPASS], sC[NPASS];
#pragma unroll
  for (int i = 0; i < NPASS; ++i) {
    const int s = i * 8 + wid;
    const int sl = s < 34 ? s : s - 34;
    stage_rc<KS>(sl * 1024 + lane * 16, sR[i], sC[i]);
  }
  int so[NPASS];
  const bf16_t* Ab = A;
  int nbrow = 0, nbcol = 0;
#define TILE_COORDS(w) do { int wgid = (w); \
      { int q = nwg / 8, r = nwg % 8, xcd = wgid % 8, off = wgid / 8; \
        wgid = (xcd < r ? xcd * (q + 1) : r * (q + 1) + (xcd - r) * q) + off; } \
      const int nig = 4 * nN, gid = wgid / nig, fm = gid * 4, gsz = min(nM - fm, 4); \
      nbrow = (fm + ((wgid % nig) % gsz)) * 272; nbcol = ((wgid % nig) / gsz) * 256; \
      Ab = A + (size_t)nbrow * K; \
      _Pragma("unroll") for (int i = 0; i < NPASS; ++i) { const int s = i * 8 + wid; \
        if (s < 34) so[i] = (sR[i] * K + sC[i]) * 2; \
        else { int br = nbcol + sR[i]; if (br > N - 1) br = N - 1; so[i] = (br * K + sC[i]) * 2; } } } while (0)
#define GLDS_PART(buf, kt, i_lo, i_hi) do { const char* ga_ = (const char*)(Ab + (kt) * BK); const char* gb_ = (const char*)(Bt + (kt) * BK); \
    _Pragma("unroll") for (int i = (i_lo); i < (i_hi); ++i) { const int s = i * 8 + wid; \
      if (s < 66) __builtin_amdgcn_global_load_lds((const unsigned*)((s < 34 ? ga_ : gb_) + (unsigned)so[i]), (unsigned*)(lds + (buf) * STAGE_B + s * 1024), 16, 0, 0); } } while (0)
#define GLDS_STAGE(buf, kt) GLDS_PART(buf, kt, 0, NPASS)
  int w0 = blockIdx.x;
  if (w0 < nwg) { TILE_COORDS(w0); GLDS_STAGE(0, 0); }
  while (w0 < nwg) {
    const int brow = nbrow, bcol = nbcol;
    f32x4 acc[9][4];
#pragma unroll
    for (int m = 0; m < 9; ++m)
#pragma unroll
      for (int n = 0; n < 4; ++n) acc[m][n] = (f32x4){0.f, 0.f, 0.f, 0.f};
    WAIT_V0(); __syncthreads();
#pragma unroll 1
    for (int t = 0; t < nt; ++t) {
      const int cur = t & 1;
      const int tn = (t + 1 < nt) ? t + 1 : t;
      const char* sa = lds + cur * STAGE_B; const char* sb = sa + TA_B;
#pragma unroll
      for (int ks = 0; ks < KS; ++ks) {
        bf16x8 Bf[4], a0, a1;
#pragma unroll
        for (int n = 0; n < 4; ++n) Bf[n] = *(const bf16x8*)(sb + lds_byte<KS>(wc * 64 + n * 16 + fr, ks * 32 + fq * 8));
        a0 = *(const bf16x8*)(sa + lds_byte<KS>(rbase + fr, ks * 32 + fq * 8));
#pragma unroll
        for (int m = 0; m < 8; ++m) {
          if (m < 7 || wr == 0) a1 = *(const bf16x8*)(sa + lds_byte<KS>(rbase + (m + 1) * 16 + fr, ks * 32 + fq * 8));
          if (ks == 0) { if (m < 5) GLDS_PART(cur ^ 1, tn, m, m + 1); } else { if (m < 4) GLDS_PART(cur ^ 1, tn, 5 + m, 6 + m); }
          __builtin_amdgcn_s_setprio(1);
#pragma unroll
          for (int n = 0; n < 4; ++n) acc[m][n] = __builtin_amdgcn_mfma_f32_16x16x32_bf16(Bf[n], a0, acc[m][n], 0, 0, 0);
          __builtin_amdgcn_s_setprio(0);
          a0 = a1;
        }
        if (wr == 0) {
#pragma unroll
          for (int n = 0; n < 4; ++n) acc[8][n] = __builtin_amdgcn_mfma_f32_16x16x32_bf16(Bf[n], a0, acc[8][n], 0, 0, 0);
        }
      }
      WAIT_V0(); __syncthreads();
    }
    w0 += gridDim.x;
    if (w0 < nwg) { TILE_COORDS(w0); GLDS_STAGE(0, 0); }
    char* est = lds + STAGE_B + wid * 6912;
    if (EPI == 0 || EPI == 1) {
#pragma unroll
      for (int pi = 0; pi < 3; ++pi) {
#pragma unroll
        for (int mm = 0; mm < 3; ++mm) {
          const int m = pi * 3 + mm;
          if (m < 8 || wr == 0) {
#pragma unroll
            for (int n = 0; n < 4; ++n) {
              f32x4 v = acc[m][n];
              if (EPI == 1) {
#pragma unroll
                for (int j = 0; j < 4; ++j) { const float a = fmaxf(v[j], 0.f); v[j] = a * a; }
              }
              uint2 o; o.x = pack2(v[0], v[1]); o.y = pack2(v[2], v[3]);
              *(uint2*)(est + (mm * 16 + fr) * 144 + (n * 16 + fq * 4) * 2) = o;
            }
          }
        }
        asm volatile("" ::: "memory");
        const int nrows = (wr == 0 || pi < 2) ? 48 : 32;
#pragma unroll
        for (int q = 0; q < 6; ++q) {
          const int idx = q * 64 + lane, rl = idx >> 3, ch = idx & 7;
          const uint4 val = *(const uint4*)(est + rl * 144 + ch * 16);
          const int row = brow + rbase + pi * 48 + rl, col = bcol + wc * 64 + ch * 8;
          if (rl < nrows && col < N) *(uint4*)(outb + (size_t)row * ldo + col) = val;
        }
        asm volatile("" ::: "memory");
      }
    } else {
      const int ch = lane & 15, rq4 = lane >> 4;
      const int col = bcol + wc * 64 + ch * 4;
      const int bidx0 = brow / NTB;
      const float4 md_lat = *(const float4*)(modv + (size_t)bidx0 * 6144 + col);
      float4 xc[4], xn[4];
#pragma unroll
      for (int q = 0; q < 4; ++q) xc[q] = *(const float4*)(xrow_src(p, brow + rbase + q * 4 + rq4, first) + col);
#pragma unroll
      for (int m = 0; m < 9; ++m) {
        if (m < 8 || wr == 0) {
#pragma unroll
          for (int n = 0; n < 4; ++n) *(f32x4*)(est + fr * 272 + (n * 16 + fq * 4) * 4) = acc[m][n];
          if (m < 7 || (m == 7 && wr == 0)) {
#pragma unroll
            for (int q = 0; q < 4; ++q) xn[q] = *(const float4*)(xrow_src(p, brow + rbase + (m + 1) * 16 + q * 4 + rq4, first) + col);
          }
          asm volatile("" ::: "memory");
#pragma unroll
          for (int q = 0; q < 4; ++q) {
            const int rl = q * 4 + rq4;
            const float4 v = *(const float4*)(est + rl * 272 + ch * 16);
            const int row = brow + rbase + m * 16 + rl;
            const bool isctx = (row - bidx0 * NTB) < 256;
            float4 md = md_lat;
            if (isctx) md = *(const float4*)(modv + (size_t)8 * 6144 + col);
            float4 cur = xc[q];
            cur.x += md.x * v.x; cur.y += md.y * v.y; cur.z += md.z * v.z; cur.w += md.w * v.w;
            *(float4*)(xrow(p, row) + col) = cur;
          }
#pragma unroll
          for (int q = 0; q < 4; ++q) xc[q] = xn[q];
          asm volatile("" ::: "memory");
        }
      }
    }
  }
}

#undef GLDS_STAGE
#undef GLDS_PART
#undef TILE_COORDS

__device__ void chain_idle() {
  for (int pos = 0; pos < NTB; ++pos) { __syncthreads(); __syncthreads(); }
}

__device__ void chain_ret(const Params& p, int layer, int item, float* wl) {
  const int lane = otid() & 63;
  const int b = item >> 4, h = (item >> 2) & 3, dir = (item >> 1) & 1, vs = item & 1;
  const int e = layer >> 1;
  const bf16_t* proj = (const bf16_t*)(p.ws + OFF_BIG);
  bf16_t* ob = (bf16_t*)(p.ws + (dir ? OFF_BUFA : OFF_BUFB));
  const float* ct = (const float*)(p.ws + OFF_ROPE); const float* st = ct + 4096 * 32;
  const float gam = expf(p.in[19][(e * 2 + dir) * 4 + h]);
  float s[64];
#pragma unroll
  for (int d = 0; d < 64; ++d) s[d] = 0.f;
  float2* qk = (float2*)wl;
  for (int pos = 0; pos < NTB; ++pos) {
    const int n = scan2nat(pos, dir);
    const size_t g = (size_t)b * NTB + n;
    const bf16_t* row = proj + g * EV_IN;
    float qv = bf2f(row[1024 + h * 64 + lane]);
    float kv = bf2f(row[1280 + h * 64 + lane]) * 0.125f;
    float vv = bf2f(row[1536 + h * 128 + vs * 64 + lane]);
    float qo = __shfl_xor(qv, 32), ko = __shfl_xor(kv, 32);
    if (n >= 256) {
      int t = n - 256, pp = lane & 31;
      float c = ct[t * 32 + pp], sn = st[t * 32 + pp];
      if (lane < 32) { qv = qv * c - qo * sn; kv = kv * c - ko * sn; }
      else { qv = qo * sn + qv * c; kv = ko * sn + kv * c; }
    }
    qk[lane] = make_float2(qv, kv);
    __syncthreads();
    float o = 0.f;
#pragma unroll
    for (int d = 0; d < 64; d += 2) {
      float4 t4 = *(const float4*)(qk + d);
      s[d] = gam * s[d] + t4.y * vv; o += t4.x * s[d];
      s[d + 1] = gam * s[d + 1] + t4.w * vv; o += t4.z * s[d + 1];
      if ((d & 7) == 6) asm volatile("" ::: "memory");
    }
    ob[g * DM + 512 + h * 128 + vs * 64 + lane] = f2bf(o);
    __syncthreads();
  }
}

__device__ void chain_lru(const Params& p, int layer, int item, float* wl) {
  const int lane = otid() & 63;
  const int part = item & 1, kb = (item >> 1) & 7, dir = (item >> 4) & 1, b = item >> 5;
  const int e = layer >> 1;
  const int dh = lane >> 5, jl = (lane & 31) + 32 * part;
  const int chu = kb * 64 + lane;
  const int cho = kb * 64 + jl;
  const bf16_t* proj = (const bf16_t*)(p.ws + OFF_BIG);
  bf16_t* ob = (bf16_t*)(p.ws + (dir ? OFF_BUFA : OFF_BUFB));
  float cw[4];
#pragma unroll
  for (int t = 0; t < 4; ++t) cw[t] = p.in[12][(e * 4 + t) * 512 + chu];
  const float cb = p.in[13][e * 512 + chu];
  float wa[32], wx[32];
  {
    const float* wap = p.in[14] + ((size_t)((e * 2 + dir) * 8 + kb) * 64 + 32 * dh) * 64 + jl;
    const float* wxp = p.in[16] + ((size_t)((e * 2 + dir) * 8 + kb) * 64 + 32 * dh) * 64 + jl;
#pragma unroll
    for (int i = 0; i < 32; ++i) { wa[i] = wap[i * 64]; wx[i] = wxp[i * 64]; }
  }
  const float ba = p.in[15][(e * 2 + dir) * 512 + cho], bx = p.in[17][(e * 2 + dir) * 512 + cho];
  const float lam = p.in[18][(e * 2 + dir) * 512 + cho];
  const float spc = -8.f * softplusf_(-lam);
  float hst = 0.f;
  const float* wlh = wl + 32 * dh;
  for (int pos = 0; pos < NTB; ++pos) {
    const int n = scan2nat(pos, dir);
    const size_t g = (size_t)b * NTB + n;
    const int lo = n < 256 ? 0 : 256, hi = n < 256 ? 256 : NTB;
    float u = cb;
#pragma unroll
    for (int t = 0; t < 4; ++t) {
      int nn = n + t - 2;
      if (nn >= lo && nn < hi) u += cw[t] * bf2f(proj[((size_t)b * NTB + nn) * EV_IN + chu]);
    }
    wl[lane] = u;
    __syncthreads();
    float rp = 0.f, ip = 0.f;
#pragma unroll
    for (int i = 0; i < 32; i += 4) {
      float4 u4 = *(const float4*)(wlh + i);
      rp += u4.x * wa[i] + u4.y * wa[i + 1] + u4.z * wa[i + 2] + u4.w * wa[i + 3];
      ip += u4.x * wx[i] + u4.y * wx[i + 1] + u4.z * wx[i + 2] + u4.w * wx[i + 3];
    }
    rp += __shfl_xor(rp, 32); ip += __shfl_xor(ip, 32);
    rp += ba; ip += bx;
    float uo = wl[jl];
    float r = sigmoidf_(rp), ig = sigmoidf_(ip);
    float la = spc * r;
    float a = expf(la);
    float bb = sqrtf(-expm1f(2.f * la)) * ig * uo;
    hst = a * hst + bb;
    if (dh == 0) ob[g * DM + cho] = f2bf(hst);
    __syncthreads();
  }
}

__device__ void chain_gla(const Params& p, int layer, int item, float* wl) {
  const int lane = otid() & 63;
  const int vs4 = item & 3, dir = (item >> 2) & 1, h = (item >> 3) & 3, b = item >> 5;
  const int o_ = layer >> 1;
  const int dh = lane >> 5, vl = lane & 31;
  const bf16_t* proj = (const bf16_t*)(p.ws + OFF_BIG);
  bf16_t* ob = (bf16_t*)(p.ws + (dir ? OFF_BUFA : OFF_BUFB));
  float lb[2];
#pragma unroll
  for (int j = 0; j < 2; ++j) {
    int d = h * 128 + lane + 64 * j;
    float l0 = p.in[21][(dir * 2 + 0) * 512 + d], l1 = p.in[21][(dir * 2 + 1) * 512 + d];
    lb[j] = o_ == 0 ? 0.f : 1.f / (1.f + expf(l0 - l1));
  }
  float s[64];
#pragma unroll
  for (int d = 0; d < 64; ++d) s[d] = 0.f;
  float4* st4 = (float4*)wl;
  const float4* st4h = st4 + 64 * dh;
  for (int pos = 0; pos < NTB; ++pos) {
    const int n = scan2nat(pos, dir);
    const size_t g = (size_t)b * NTB + n;
    const bf16_t* row = proj + g * OD_IN;
#pragma unroll
    for (int j = 0; j < 2; ++j) {
      int d = lane + 64 * j;
      float hq = bf2f(row[h * 128 + d]);
      float fp = bf2f(row[(dir ? 1024 : 512) + h * 128 + d]);
      float sg = sigmoidf_(fp);
      float f = lb[j] + (1.f - lb[j]) * sg;
      st4[d] = make_float4(f, 1.f - f, siluf_(hq), 0.f);
    }
    float vv = bf2f(row[1536 + h * 128 + vs4 * 32 + vl]);
    __syncthreads();
    float o = 0.f;
#pragma unroll
    for (int d = 0; d < 64; ++d) {
      float4 t4 = st4h[d];
      s[d] = t4.x * s[d] + t4.y * vv; o += t4.z * s[d];
      if ((d & 3) == 3) asm volatile("" ::: "memory");
    }
    o += __shfl_xor(o, 32);
    if (dh == 0) ob[g * DM + h * 128 + vs4 * 32 + vl] = f2bf(o);
    __syncthreads();
  }
}

__device__ void chain_gdn(const Params& p, int layer, int item, float* wl) {
  const int lane = otid() & 63;
  const int vs4 = item & 3, dir = (item >> 2) & 1, h = (item >> 3) & 3, b = item >> 5;
  const int o_ = layer >> 1;
  const int dh = lane >> 5, vl = lane & 31;
  const bf16_t* proj = (const bf16_t*)(p.ws + OFF_BIG);
  bf16_t* ob = (bf16_t*)(p.ws + (dir ? OFF_BUFA : OFF_BUFB));
  int cch[5], pcol[5];
  cch[0] = h * 128 + lane;        pcol[0] = 2560 + cch[0];
  cch[1] = h * 128 + lane + 64;   pcol[1] = 2560 + cch[1];
  cch[2] = 512 + h * 128 + lane;  pcol[2] = 2560 + cch[2];
  cch[3] = 512 + h * 128 + lane + 64; pcol[3] = 2560 + cch[3];
  cch[4] = 1024 + h * 128 + vs4 * 32 + vl; pcol[4] = 2560 + cch[4];
  float cw[5][4];
#pragma unroll
  for (int j = 0; j < 5; ++j)
#pragma unroll
    for (int t = 0; t < 4; ++t) cw[j][t] = p.in[22][((size_t)o_ * 4 + t) * 1536 + cch[j]];
  const float aexp = expf(p.in[23][(o_ * 2 + dir) * 4 + h]);
  const float dtb = p.in[24][(o_ * 2 + dir) * 4 + h];
  float s[64];
#pragma unroll
  for (int d = 0; d < 64; ++d) s[d] = 0.f;
  float2* qk = (float2*)wl;
  const float2* qkh = qk + 64 * dh;
  for (int pos = 0; pos < NTB; ++pos) {
    const int n = scan2nat(pos, dir);
    const size_t g = (size_t)b * NTB + n;
    const int lo = n < 256 ? 0 : 256, hi = n < 256 ? 256 : NTB;
    float cv[5];
#pragma unroll
    for (int j = 0; j < 5; ++j) cv[j] = 0.f;
#pragma unroll
    for (int t = 0; t < 4; ++t) {
      int nn = n + t - 2;
      if (nn >= lo && nn < hi) {
        const bf16_t* rr = proj + ((size_t)b * NTB + nn) * OD_IN;
#pragma unroll
        for (int j = 0; j < 5; ++j) cv[j] += cw[j][t] * bf2f(rr[pcol[j]]);
      }
    }
#pragma unroll
    for (int j = 0; j < 5; ++j) cv[j] = siluf_(cv[j]);
    float sq = wave_sum(cv[0] * cv[0] + cv[1] * cv[1]);
    float sk = wave_sum(cv[2] * cv[2] + cv[3] * cv[3]);
    float rq = rsqrtf(sq + 1e-6f) * 0.08838834764831845f, rk = rsqrtf(sk + 1e-6f);
    qk[lane] = make_float2(cv[0] * rq, cv[2] * rk);
    qk[lane + 64] = make_float2(cv[1] * rq, cv[3] * rk);
    const bf16_t* row = proj + g * OD_IN;
    float beta = sigmoidf_(bf2f(row[4608 + dir * 4 + h]));
    float gg = -aexp * softplusf_(bf2f(row[4616 + dir * 4 + h]) + dtb);
    float alpha = expf(gg);
    __syncthreads();
    float kS = 0.f;
#pragma unroll
    for (int d = 0; d < 64; d += 2) {
      float4 t4 = *(const float4*)(qkh + d);
      kS += t4.y * s[d] + t4.w * s[d + 1];
      if ((d & 7) == 6) asm volatile("" ::: "memory");
    }
    kS += __shfl_xor(kS, 32);
    float vn = beta * (cv[4] - alpha * kS);
    float o = 0.f;
#pragma unroll
    for (int d = 0; d < 64; d += 2) {
      float4 t4 = *(const float4*)(qkh + d);
      s[d] = alpha * s[d] + t4.y * vn; o += t4.x * s[d];
      s[d + 1] = alpha * s[d + 1] + t4.w * vn; o += t4.z * s[d + 1];
      if ((d & 7) == 6) asm volatile("" ::: "memory");
    }
    o += __shfl_xor(o, 32);
    if (dh == 0) ob[g * DM + 512 + h * 128 + vs4 * 32 + vl] = f2bf(o);
    __syncthreads();
  }
}

template <int TM, int TN, int K>
__device__ __forceinline__ void lds_mma(const bf16_t* A, int lda, const bf16_t* B, int ldb, int m0, int n0, f32x4 (&acc)[TM][TN], int lane) {
  const int l15 = lane & 15, quad = lane >> 4;
  const bf16_t* ap = A + (m0 + l15) * lda + quad * 8;
  const bf16_t* bp = B + (n0 + l15) * ldb + quad * 8;
#pragma unroll
  for (int k = 0; k < K; k += 32) {
    bf16x8 a[TM], b[TN];
#pragma unroll
    for (int i = 0; i < TM; ++i) a[i] = *(const bf16x8*)(ap + i * 16 * lda + k);
#pragma unroll
    for (int j = 0; j < TN; ++j) b[j] = *(const bf16x8*)(bp + j * 16 * ldb + k);
#pragma unroll
    for (int i = 0; i < TM; ++i)
#pragma unroll
      for (int j = 0; j < TN; ++j) acc[i][j] = __builtin_amdgcn_mfma_f32_16x16x32_bf16(a[i], b[j], acc[i][j], 0, 0, 0);
  }
}
__device__ __forceinline__ void unpack8(uint4 u, float* f) {
  f[0] = __uint_as_float(u.x << 16); f[1] = __uint_as_float(u.x & 0xffff0000u);
  f[2] = __uint_as_float(u.y << 16); f[3] = __uint_as_float(u.y & 0xffff0000u);
  f[4] = __uint_as_float(u.z << 16); f[5] = __uint_as_float(u.z & 0xffff0000u);
  f[6] = __uint_as_float(u.w << 16); f[7] = __uint_as_float(u.w & 0xffff0000u);
}
__device__ __forceinline__ uint4 pack8(const float* f) {
  uint4 u; u.x = pack2(f[0], f[1]); u.y = pack2(f[2], f[3]); u.z = pack2(f[4], f[5]); u.w = pack2(f[6], f[7]); return u;
}

__device__ __forceinline__ void cret(const Params& p, int layer, int item, char* lds) {
  const int tid = otid(), lane = tid & 63, wave = tid >> 6, l15 = lane & 15, quad = lane >> 4;
  const int b = item >> 4, h = (item >> 2) & 3, dir = (item >> 1) & 1, vs = item & 1;
  const int e = layer >> 1;
  const bf16_t* proj = (const bf16_t*)(p.ws + OFF_BIG);
  bf16_t* ob = (bf16_t*)(p.ws + (dir ? OFF_BUFA : OFF_BUFB));
  const float* ct = (const float*)(p.ws + OFF_ROPE); const float* st = ct + 4096 * 32;
  const float lg = p.in[19][(e * 2 + dir) * 4 + h];
  bf16_t* PQ = (bf16_t*)lds;
  bf16_t* Ks = PQ + 128 * 200;
  bf16_t* KT = Ks + 128 * 72;
  bf16_t* VB = KT + 64 * 136;
  bf16_t* V2T = VB + 64 * 200;
  const float cdec = __expf(lg * 128.f);
  f32x4 S[1][2];
  S[0][0] = (f32x4){0.f, 0.f, 0.f, 0.f}; S[0][1] = S[0][0];
  for (int i = tid; i < 64 * 64; i += NTHREADS) VB[(i >> 6) * 200 + 128 + (i & 63)] = 0;
  const int si = tid >> 2, sq = tid & 3;
  const float qd = __expf(lg * (float)(si + 1)), kd = __expf(lg * (float)(127 - si));
  uint4 rr_[6]; float4 rc_[4];
  int rn_ = 0;
#define RET_LOAD(cc) do { rn_ = scan2nat((cc) * 128 + si, dir); const bf16_t* row_ = proj + ((size_t)b * NTB + rn_) * EV_IN; \
    rr_[0] = *(const uint4*)(row_ + 1024 + h * 64 + 8 * sq); rr_[1] = *(const uint4*)(row_ + 1024 + h * 64 + 32 + 8 * sq); \
    rr_[2] = *(const uint4*)(row_ + 1280 + h * 64 + 8 * sq); rr_[3] = *(const uint4*)(row_ + 1280 + h * 64 + 32 + 8 * sq); \
    rr_[4] = *(const uint4*)(row_ + 1536 + h * 128 + vs * 64 + 16 * sq); rr_[5] = *(const uint4*)(row_ + 1536 + h * 128 + vs * 64 + 16 * sq + 8); \
    { const int tt_ = rn_ >= 256 ? rn_ - 256 : 0; const float* cp_ = ct + tt_ * 32 + 8 * sq; const float* sp_ = st + tt_ * 32 + 8 * sq; \
      rc_[0] = *(const float4*)cp_; rc_[1] = *(const float4*)(cp_ + 4); rc_[2] = *(const float4*)sp_; rc_[3] = *(const float4*)(sp_ + 4); } } while (0)
  RET_LOAD(0);
  for (int c = 0; c < 34; ++c) {
    {
      const int n = rn_;
      float q1[8], q2[8], k1[8], k2[8];
      unpack8(rr_[0], q1);
      unpack8(rr_[1], q2);
      unpack8(rr_[2], k1);
      unpack8(rr_[3], k2);
      float vv[16];
      unpack8(rr_[4], vv);
      unpack8(rr_[5], vv + 8);
      float cc[8], ss[8];
      *(float4*)cc = rc_[0]; *(float4*)(cc + 4) = rc_[1];
      *(float4*)ss = rc_[2]; *(float4*)(ss + 4) = rc_[3];
      if (c + 1 < 34) RET_LOAD(c + 1);
      if (n >= 256) {
#pragma unroll
        for (int j = 0; j < 8; ++j) {
          float a1 = q1[j] * cc[j] - q2[j] * ss[j], a2 = q1[j] * ss[j] + q2[j] * cc[j]; q1[j] = a1; q2[j] = a2;
          float b1 = k1[j] * cc[j] - k2[j] * ss[j], b2 = k1[j] * ss[j] + k2[j] * cc[j]; k1[j] = b1; k2[j] = b2;
        }
      }
#pragma unroll
      for (int j = 0; j < 8; ++j) { q1[j] *= qd; q2[j] *= qd; k1[j] *= 0.125f; k2[j] *= 0.125f; }
      *(uint4*)(PQ + si * 200 + 128 + 8 * sq) = pack8(q1);
      *(uint4*)(PQ + si * 200 + 160 + 8 * sq) = pack8(q2);
      *(uint4*)(Ks + si * 72 + 8 * sq) = pack8(k1);
      *(uint4*)(Ks + si * 72 + 32 + 8 * sq) = pack8(k2);
#pragma unroll
      for (int j = 0; j < 8; ++j) { KT[(8 * sq + j) * 136 + si] = f2bf(k1[j]); KT[(32 + 8 * sq + j) * 136 + si] = f2bf(k2[j]); }
#pragma unroll
      for (int j = 0; j < 16; ++j) { VB[(16 * sq + j) * 200 + si] = f2bf(vv[j]); V2T[(16 * sq + j) * 136 + si] = f2bf(vv[j] * kd); }
    }
    __syncthreads();
    {
      const int m0 = wave * 16;
#pragma unroll
      for (int nt = 0; nt < 8; ++nt) {
        f32x4 acc[1][1]; acc[0][0] = (f32x4){0.f, 0.f, 0.f, 0.f};
        if (nt <= wave) lds_mma<1, 1, 64>(PQ + 128, 200, Ks, 72, m0, nt * 16, acc, lane);
        const int j = nt * 16 + l15;
        const float sc = __expf(-lg * (float)(j + 1));
#pragma unroll
        for (int r = 0; r < 4; ++r) {
          const int i = m0 + quad * 4 + r;
          float v = (nt <= wave && i >= j) ? acc[0][0][r] * sc : 0.f;
          PQ[i * 200 + j] = f2bf(v);
        }
      }
    }
    __syncthreads();
    {
      const int m0 = wave * 16;
      f32x4 acc[1][4];
#pragma unroll
      for (int j = 0; j < 4; ++j) acc[0][j] = (f32x4){0.f, 0.f, 0.f, 0.f};
      lds_mma<1, 4, 192>(PQ, 200, VB, 200, m0, 0, acc, lane);
#pragma unroll
      for (int r = 0; r < 4; ++r) {
        const int i = m0 + quad * 4 + r;
        const int n = scan2nat(c * 128 + i, dir);
        bf16_t* orow = ob + ((size_t)b * NTB + n) * DM + 512 + h * 128 + vs * 64 + l15;
#pragma unroll
        for (int j = 0; j < 4; ++j) orow[j * 16] = f2bf(acc[0][j][r]);
      }
    }
    const int sm0 = (wave >> 1) * 16, sn0 = (wave & 1) * 32;
    {
      S[0][0] *= cdec; S[0][1] *= cdec;
      lds_mma<1, 2, 128>(KT, 136, V2T, 136, sm0, sn0, S, lane);
    }
    __syncthreads();
#pragma unroll
    for (int j = 0; j < 2; ++j) {
      const int v = sn0 + j * 16 + l15, d = sm0 + quad * 4;
      uint2 u; u.x = pack2(S[0][j][0], S[0][j][1]); u.y = pack2(S[0][j][2], S[0][j][3]);
      *(uint2*)(VB + v * 200 + 128 + d) = u;
    }
  }
  __syncthreads();
}

__device__ __forceinline__ void clru(const Params& p, int layer, int item, char* lds) {
  const int tid = otid(), lane = tid & 63, wave = tid >> 6, l15 = lane & 15, quad = lane >> 4;
  const int kb = item & 7, dir = (item >> 3) & 1, b = item >> 4;
  const int e = layer >> 1;
  const bf16_t* proj = (const bf16_t*)(p.ws + OFF_BIG);
  bf16_t* ob = (bf16_t*)(p.ws + (dir ? OFF_BUFA : OFF_BUFB));
  bf16_t* Wt = (bf16_t*)lds;
  bf16_t* Ub = Wt + 128 * 72;
  float* Uf = (float*)(Ub + 64 * 72);
  float* LA = Uf + 64 * 64;
  float* IG = LA + 64 * 64;
  float* Hs = IG + 64 * 64;
  {
    const float* wap = p.in[14] + ((size_t)((e * 2 + dir) * 8 + kb) * 64) * 64;
    const float* wxp = p.in[16] + ((size_t)((e * 2 + dir) * 8 + kb) * 64) * 64;
    for (int i = tid; i < 4096; i += NTHREADS) {
      int ii = i >> 6, jj = i & 63;
      Wt[jj * 72 + ii] = f2bf(wap[i]);
      Wt[(64 + jj) * 72 + ii] = f2bf(wxp[i]);
    }
  }
  const int si = tid >> 3, sp = tid & 7;
  float cw[4][8], cb[8];
#pragma unroll
  for (int j = 0; j < 8; ++j) {
    const int ch = kb * 64 + sp * 8 + j;
    cb[j] = p.in[13][e * 512 + ch];
#pragma unroll
    for (int t = 0; t < 4; ++t) cw[t][j] = p.in[12][(e * 4 + t) * 512 + ch];
  }
  float gba[2], gbx[2], gsl[2];
#pragma unroll
  for (int t = 0; t < 2; ++t) {
    const int ch = kb * 64 + (wave & 1) * 32 + t * 16 + l15;
    gba[t] = p.in[15][(e * 2 + dir) * 512 + ch];
    gbx[t] = p.in[17][(e * 2 + dir) * 512 + ch];
    gsl[t] = -8.f * softplusf_(-p.in[18][(e * 2 + dir) * 512 + ch]);
  }
  float hst = 0.f;
  __syncthreads();
  uint4 rx[4];
#define LRU_LOAD(cc) do { const int n_ = scan2nat((cc) * 64 + si, dir); const int lo_ = n_ < 256 ? 0 : 256, hi_ = n_ < 256 ? 256 : NTB; \
    _Pragma("unroll") for (int t = 0; t < 4; ++t) { const int nn = n_ + t - 2; const bool ok = (nn >= lo_ && nn < hi_); \
      const uint4 v_ = *(const uint4*)(proj + ((size_t)b * NTB + (ok ? nn : n_)) * EV_IN + kb * 64 + sp * 8); \
      rx[t] = ok ? v_ : make_uint4(0u, 0u, 0u, 0u); } } while (0)
  LRU_LOAD(0);
  for (int c = 0; c < 68; ++c) {
    {
      float u[8];
#pragma unroll
      for (int j = 0; j < 8; ++j) u[j] = cb[j];
#pragma unroll
      for (int t = 0; t < 4; ++t) {
        float xv[8];
        unpack8(rx[t], xv);
#pragma unroll
        for (int j = 0; j < 8; ++j) u[j] += cw[t][j] * xv[j];
      }
      if (c + 1 < 68) LRU_LOAD(c + 1);
      *(float4*)(Uf + si * 64 + sp * 8) = *(float4*)u;
      *(float4*)(Uf + si * 64 + sp * 8 + 4) = *(float4*)(u + 4);
      *(uint4*)(Ub + si * 72 + sp * 8) = pack8(u);
    }
    __syncthreads();
    {
      const int m0 = (wave >> 1) * 16, n0 = (wave & 1) * 32;
      f32x4 ar[1][2], ai[1][2];
      ar[0][0] = (f32x4){0.f, 0.f, 0.f, 0.f}; ar[0][1] = ar[0][0]; ai[0][0] = ar[0][0]; ai[0][1] = ar[0][0];
      lds_mma<1, 2, 64>(Ub, 72, Wt, 72, m0, n0, ar, lane);
      lds_mma<1, 2, 64>(Ub, 72, Wt, 72, m0, 64 + n0, ai, lane);
#pragma unroll
      for (int t = 0; t < 2; ++t) {
        const int jj = n0 + t * 16 + l15;
#pragma unroll
        for (int r = 0; r < 4; ++r) {
          const int i = m0 + quad * 4 + r;
          const float la = gsl[t] * sigmoidf_(ar[0][t][r] + gba[t]);
          const float ig = sigmoidf_(ai[0][t][r] + gbx[t]);
          const float a = __expf(la);
          LA[i * 64 + jj] = a;
          IG[i * 64 + jj] = __builtin_amdgcn_sqrtf(fmaxf(1.f - a * a, 0.f)) * ig * Uf[i * 64 + jj];
        }
      }
    }
    __syncthreads();
    if (wave == 0) {
#pragma unroll
      for (int bq = 0; bq < 4; ++bq) {
        float av[16], bv[16];
#pragma unroll
        for (int i = 0; i < 16; ++i) { av[i] = LA[(bq * 16 + i) * 64 + lane]; bv[i] = IG[(bq * 16 + i) * 64 + lane]; }
#pragma unroll
        for (int i = 0; i < 16; ++i) { hst = av[i] * hst + bv[i]; Hs[(bq * 16 + i) * 64 + lane] = hst; }
      }
    }
    __syncthreads();
    {
      const int n = scan2nat(c * 64 + si, dir);
      float hv[8];
      *(float4*)hv = *(const float4*)(Hs + si * 64 + sp * 8);
      *(float4*)(hv + 4) = *(const float4*)(Hs + si * 64 + sp * 8 + 4);
      *(uint4*)(ob + ((size_t)b * NTB + n) * DM + kb * 64 + sp * 8) = pack8(hv);
    }
  }
  __syncthreads();
}

__device__ __forceinline__ void cgla(const Params& p, int layer, int item, char* lds) {
  const int tid = otid(), lane = tid & 63, wave = tid >> 6, l15 = lane & 15, quad = lane >> 4;
  const int b = item >> 4, h = (item >> 2) & 3, dir = (item >> 1) & 1, vs = item & 1;
  const int o_ = layer >> 1;
  const bf16_t* proj = (const bf16_t*)(p.ws + OFF_BIG);
  bf16_t* ob = (bf16_t*)(p.ws + (dir ? OFF_BUFA : OFF_BUFB));
  float* AF = (float*)lds;
  bf16_t* PQ = (bf16_t*)(lds + 32768);
  bf16_t* Qt = PQ + 64 * 200;
  bf16_t* Kt = Qt + 64 * 136;
  bf16_t* VB = Kt + 64 * 136;
  bf16_t* K3T = VB + 64 * 200;
  float* LB = (float*)(K3T + 128 * 72);
  if (tid < 128) {
    const int d = h * 128 + tid;
    float l0 = p.in[21][(dir * 2 + 0) * 512 + d], l1 = p.in[21][(dir * 2 + 1) * 512 + d];
    LB[tid] = o_ == 0 ? 0.f : 1.f / (1.f + __expf(l0 - l1));
  }
  for (int i = tid; i < 64 * 128; i += NTHREADS) VB[(i >> 7) * 200 + 64 + (i & 127)] = 0;
  f32x4 S[1][4];
#pragma unroll
  for (int j = 0; j < 4; ++j) S[0][j] = (f32x4){0.f, 0.f, 0.f, 0.f};
  const int si = tid >> 3, sp = tid & 7;
  __syncthreads();
  for (int c = 0; c < 68; ++c) {
    float qr[16], kr[16];
    const int n_s = scan2nat(c * 64 + si, dir);
    const bf16_t* row = proj + ((size_t)b * NTB + n_s) * OD_IN;
    {
      float fp[16];
      unpack8(*(const uint4*)(row + h * 128 + 16 * sp), qr);
      unpack8(*(const uint4*)(row + h * 128 + 16 * sp + 8), qr + 8);
      unpack8(*(const uint4*)(row + (dir ? 1024 : 512) + h * 128 + 16 * sp), fp);
      unpack8(*(const uint4*)(row + (dir ? 1024 : 512) + h * 128 + 16 * sp + 8), fp + 8);
#pragma unroll
      for (int j = 0; j < 16; ++j) {
        const float lb = LB[16 * sp + j];
        const float f = lb + (1.f - lb) * sigmoidf_(fp[j]);
        kr[j] = 1.f - f;
        qr[j] = siluf_(qr[j]);
        AF[si * 128 + 16 * sp + j] = __logf(f);
      }
      float vv[8];
      unpack8(*(const uint4*)(row + 1536 + h * 128 + vs * 64 + 8 * sp), vv);
#pragma unroll
      for (int j = 0; j < 8; ++j) VB[(8 * sp + j) * 200 + si] = f2bf(vv[j]);
    }
    __syncthreads();
    if (tid < 128) {
      float a = 0.f;
#pragma unroll 8
      for (int i = 0; i < 64; ++i) { a += AF[i * 128 + tid]; AF[i * 128 + tid] = a; }
    }
    __syncthreads();
    {
      float t1[16], t2[16], t3[16];
#pragma unroll
      for (int j = 0; j < 16; ++j) {
        const int d = 16 * sp + j;
        const float a = AF[si * 128 + d], rr = AF[31 * 128 + d], al = AF[63 * 128 + d];
        t1[j] = qr[j] * __expf(a - rr);
        t2[j] = kr[j] * __expf(rr - a);
        t3[j] = qr[j] * __expf(a);
        K3T[d * 72 + si] = f2bf(kr[j] * __expf(al - a));
      }
      *(uint4*)(Qt + si * 136 + 16 * sp) = pack8(t1); *(uint4*)(Qt + si * 136 + 16 * sp + 8) = pack8(t1 + 8);
      *(uint4*)(Kt + si * 136 + 16 * sp) = pack8(t2); *(uint4*)(Kt + si * 136 + 16 * sp + 8) = pack8(t2 + 8);
      *(uint4*)(PQ + si * 200 + 64 + 16 * sp) = pack8(t3); *(uint4*)(PQ + si * 200 + 64 + 16 * sp + 8) = pack8(t3 + 8);
    }
    __syncthreads();
    {
      const int m0 = (wave >> 1) * 16, n0 = (wave & 1) * 32;
      f32x4 acc[1][2]; acc[0][0] = (f32x4){0.f, 0.f, 0.f, 0.f}; acc[0][1] = acc[0][0];
      lds_mma<1, 2, 128>(Qt, 136, Kt, 136, m0, n0, acc, lane);
#pragma unroll
      for (int j = 0; j < 2; ++j)
#pragma unroll
        for (int r = 0; r < 4; ++r) {
          const int i = m0 + quad * 4 + r, jj = n0 + j * 16 + l15;
          PQ[i * 200 + jj] = f2bf(i >= jj ? acc[0][j][r] : 0.f);
        }
    }
    __syncthreads();
    {
      const int m0 = (wave >> 1) * 16, n0 = (wave & 1) * 32;
      f32x4 acc[1][2]; acc[0][0] = (f32x4){0.f, 0.f, 0.f, 0.f}; acc[0][1] = acc[0][0];
      lds_mma<1, 2, 192>(PQ, 200, VB, 200, m0, n0, acc, lane);
#pragma unroll
      for (int r = 0; r < 4; ++r) {
        const int i = m0 + quad * 4 + r;
        const int n = scan2nat(c * 64 + i, dir);
        bf16_t* orow = ob + ((size_t)b * NTB + n) * DM + h * 128 + vs * 64 + n0 + l15;
        orow[0] = f2bf(acc[0][0][r]); orow[16] = f2bf(acc[0][1][r]);
      }
    }
    {
      const int m0 = wave * 16;
#pragma unroll
      for (int r = 0; r < 4; ++r) {
        const float dec = __expf(AF[63 * 128 + m0 + quad * 4 + r]);
#pragma unroll
        for (int j = 0; j < 4; ++j) S[0][j][r] *= dec;
      }
      lds_mma<1, 4, 64>(K3T, 72, VB, 200, m0, 0, S, lane);
    }
    __syncthreads();
#pragma unroll
    for (int j = 0; j < 4; ++j) {
      const int v = j * 16 + l15, d = wave * 16 + quad * 4;
      uint2 u; u.x = pack2(S[0][j][0], S[0][j][1]); u.y = pack2(S[0][j][2], S[0][j][3]);
      *(uint2*)(VB + v * 200 + 64 + d) = u;
    }
  }
  __syncthreads();
}

#define OFF_GC   506527744ull
#define OFF_BETA 507641856ull
__device__ __forceinline__ void gdn_prep_phase(const Params& p, int layer, char* lds) {
  const int tid = otid(), lane = tid & 63, wave = tid >> 6, l15 = lane & 15, quad = lane >> 4;
  const int o_ = layer >> 1;
  const bf16_t* proj = (const bf16_t*)(p.ws + OFF_BIG);
  bf16_t* Ks = (bf16_t*)lds;
  float* KK = (float*)(Ks + 64 * 136);
  float* Mf = KK + 64 * 68;
  float* CWA = Mf + 2 * 64 * 68;
  float* sm = CWA + 2048;
  float* gcg = (float*)(p.ws + OFF_GC);
  float* btg = (float*)(p.ws + OFF_BETA);
  const int si = tid >> 3, sp = tid & 7;
  for (int i = tid; i < 2048; i += NTHREADS) {
    const int hh = i >> 9, t = (i >> 7) & 3, d = i & 127;
    CWA[i] = p.in[22][((size_t)o_ * 4 + t) * 1536 + 512 + hh * 128 + d];
  }
  uint4 pk[4][2]; float pgb = 0.f, pga = 0.f;
#define PREP_LOAD(it_) do { const int cn_ = (it_) % 68, h_ = ((it_) / 68) & 3, b_ = (it_) / 272; \
    const int n_ = cn_ * 64 + si; const int lo_ = n_ < 256 ? 0 : 256, hi_ = n_ < 256 ? 256 : NTB; \
    _Pragma("unroll") for (int t = 0; t < 4; ++t) { const int nn = n_ + t - 2; const bool ok = (nn >= lo_ && nn < hi_); \
      const bf16_t* rr = proj + ((size_t)b_ * NTB + (ok ? nn : n_)) * OD_IN + 3072 + h_ * 128 + 16 * sp; \
      const uint4 a_ = *(const uint4*)rr, c_ = *(const uint4*)(rr + 8); \
      pk[t][0] = ok ? a_ : make_uint4(0u, 0u, 0u, 0u); pk[t][1] = ok ? c_ : make_uint4(0u, 0u, 0u, 0u); } \
    if (wave < 2) { const int ng_ = wave ? (cn_ * 64 + 63 - lane) : (cn_ * 64 + lane); \
      const bf16_t* row_ = proj + ((size_t)b_ * NTB + ng_) * OD_IN; \
      pgb = bf2f(row_[4608 + wave * 4 + h_]); pga = bf2f(row_[4616 + wave * 4 + h_]); } } while (0)
  if ((int)blockIdx.x < 8 * 4 * 68) PREP_LOAD((int)blockIdx.x);
  __syncthreads();
  for (int item = blockIdx.x; item < 8 * 4 * 68; item += gridDim.x) {
    const int cn = item % 68, h = (item / 68) & 3, b = item / 272;
    const int n0 = cn * 64;
    {
      float ak[16];
#pragma unroll
      for (int j = 0; j < 16; ++j) ak[j] = 0.f;
#pragma unroll
      for (int t = 0; t < 4; ++t) {
        float x[16];
        unpack8(pk[t][0], x); unpack8(pk[t][1], x + 8);
#pragma unroll
        for (int j = 0; j < 16; ++j) ak[j] += CWA[(h * 4 + t) * 128 + 16 * sp + j] * x[j];
      }
      float sk = 0.f;
#pragma unroll
      for (int j = 0; j < 16; ++j) { ak[j] = siluf_(ak[j]); sk += ak[j] * ak[j]; }
      sk = oct_sum(sk);
      const float rk = rsqrtf(sk + 1e-6f);
#pragma unroll
      for (int j = 0; j < 16; ++j) ak[j] *= rk;
      *(uint4*)(Ks + si * 136 + 16 * sp) = pack8(ak); *(uint4*)(Ks + si * 136 + 16 * sp + 8) = pack8(ak + 8);
    }
    const float gbv = pgb, gav = pga;
    if (item + (int)gridDim.x < 8 * 4 * 68) PREP_LOAD(item + (int)gridDim.x);
    if (wave < 2) {
      const int dir = wave;
      const int n = dir ? (n0 + 63 - lane) : (n0 + lane);
      const float aexp = __expf(p.in[23][(o_ * 2 + dir) * 4 + h]);
      const float dtb = p.in[24][(o_ * 2 + dir) * 4 + h];
      const float beta = sigmoidf_(gbv);
      float v = -aexp * softplusf_(gav + dtb);
#pragma unroll
      for (int off = 1; off < 64; off <<= 1) { float t = __shfl_up(v, off); if (lane >= off) v += t; }
      sm[(dir * 2 + 0) * 64 + lane] = beta;
      sm[(dir * 2 + 1) * 64 + lane] = v;
      const size_t gi = ((size_t)((b * 4 + h) * 2 + dir)) * NTB + n;
      gcg[gi] = v; btg[gi] = beta;
    }
    __syncthreads();
    {
      const int m0 = (wave >> 1) * 16, nn0 = (wave & 1) * 32;
      f32x4 acc[1][2]; acc[0][0] = (f32x4){0.f, 0.f, 0.f, 0.f}; acc[0][1] = acc[0][0];
      lds_mma<1, 2, 128>(Ks, 136, Ks, 136, m0, nn0, acc, lane);
#pragma unroll
      for (int j = 0; j < 2; ++j)
#pragma unroll
        for (int r = 0; r < 4; ++r) KK[(m0 + quad * 4 + r) * 68 + nn0 + j * 16 + l15] = acc[0][j][r];
    }
    __syncthreads();
    for (int idx = tid; idx < 2 * 4096; idx += NTHREADS) {
      const int dir = idx >> 12, is = (idx >> 6) & 63, js = idx & 63;
      const int in_ = dir ? 63 - is : is, jn = dir ? 63 - js : js;
      float val = 0.f;
      if (js < is) val = sm[(dir * 2) * 64 + is] * KK[in_ * 68 + jn] * __expf(sm[(dir * 2 + 1) * 64 + is] - sm[(dir * 2 + 1) * 64 + js]);
      Mf[(dir * 64 + is) * 68 + (js & 3) * 16 + (js >> 2)] = val;
    }
    __syncthreads();
    {
      const int dir = tid >> 8, col = (tid & 255) >> 2, q = tid & 3;
      const float* M = Mf + dir * 64 * 68 + q * 16;
      bf16_t* obp = (bf16_t*)(p.ws + (dir ? OFF_BUFA : OFF_BUFB)) + (size_t)b * NTB * DM + 512 + h * 128 + col;
      float xo[16], mc[16], mn[16];
#pragma unroll
      for (int m = 0; m < 16; ++m) { xo[m] = 0.f; mc[m] = 0.f; mn[m] = 0.f; }
#pragma unroll
      for (int i = 0; i < 64; ++i) {
        if (i < 63) {
#pragma unroll
          for (int m4 = 0; m4 <= (i >> 4); ++m4) *(float4*)(mn + 4 * m4) = *(const float4*)(M + (i + 1) * 68 + 4 * m4);
        }
        float part = 0.f;
        if (i > 0) {
#pragma unroll
          for (int m = 0; m <= ((i - 1) >> 2); ++m) part += mc[m] * xo[m];
        }
        part = quad_sum(part);
        const float xi = ((i == col) ? 1.f : 0.f) - part;
        if ((i & 3) == q) xo[i >> 2] = xi;
        if (q == 0) {
          const int n = dir ? (n0 + 63 - i) : (n0 + i);
          const bf16_t xb = f2bf(xi);
          obp[(size_t)n * DM] = xb; obp[(size_t)n * DM + 64] = xb;
        }
#pragma unroll
        for (int m = 0; m < 16; ++m) mc[m] = mn[m];
      }
    }
    __syncthreads();
  }
}

#undef PREP_LOAD
__device__ __forceinline__ void cgdn(const Params& p, int layer, int item, char* lds) {
  const int tid = otid(), lane = tid & 63, wave = tid >> 6, l15 = lane & 15, quad = lane >> 4;
  const int b = item >> 4, h = (item >> 2) & 3, dir = (item >> 1) & 1, vs = item & 1;
  const int o_ = layer >> 1;
  const bf16_t* proj = (const bf16_t*)(p.ws + OFF_BIG);
  bf16_t* ob = (bf16_t*)(p.ws + (dir ? OFF_BUFA : OFF_BUFB));
  const float* gcg = (const float*)(p.ws + OFF_GC) + ((size_t)((b * 4 + h) * 2 + dir)) * NTB;
  const float* btg = (const float*)(p.ws + OFF_BETA) + ((size_t)((b * 4 + h) * 2 + dir)) * NTB;
  bf16_t* Qs = (bf16_t*)lds;
  bf16_t* Ks = Qs + 64 * 136;
  bf16_t* KT = Ks + 64 * 136;
  bf16_t* Ks2 = KT + 128 * 72;
  bf16_t* Tm = Ks2 + 64 * 136;
  bf16_t* PQ = Tm + 64 * 72;
  bf16_t* VB = PQ + 64 * 200;
  bf16_t* V2T = VB + 64 * 200;
  bf16_t* RT = V2T + 64 * 72;
  float* CW = (float*)(RT + 64 * 72);
  float* gcs = CW + 4 * 320;
  float* e2 = gcs + 64;
  for (int i = tid; i < 4 * 320; i += NTHREADS) {
    const int t = i / 320, cc = i % 320;
    const int ch = cc < 128 ? (h * 128 + cc) : cc < 256 ? (512 + h * 128 + cc - 128) : (1024 + h * 128 + vs * 64 + cc - 256);
    CW[i] = p.in[22][((size_t)o_ * 4 + t) * 1536 + ch];
  }
  for (int i = tid; i < 64 * 128; i += NTHREADS) VB[(i >> 7) * 200 + 64 + (i & 127)] = 0;
  f32x4 S[1][4];
#pragma unroll
  for (int j = 0; j < 4; ++j) S[0][j] = (f32x4){0.f, 0.f, 0.f, 0.f};
  const int si = tid >> 3, sp = tid & 7;
  const int tp = tid >> 4, cg = tid & 15;
  const int m0 = (wave >> 1) * 16, n0 = (wave & 1) * 32;
  uint4 rq[5], rk[5], rtt; uint2 rv[5]; float rg0, rg1, rb0, rb1, rgl;
#define GDN_LOAD(cc) do { \
    const int na_ = scan2nat((cc) * 64 + 2 * tp, dir); \
    const int nlo_ = dir ? na_ - 1 : na_; \
    const int lo_ = nlo_ < 256 ? 0 : 256, hi_ = nlo_ < 256 ? 256 : NTB; \
    const int nb_ = dir ? na_ - 1 : na_ + 1; \
    rg0 = gcg[na_]; rg1 = gcg[nb_]; rb0 = btg[na_]; rb1 = btg[nb_]; rgl = gcg[scan2nat((cc) * 64 + 63, dir)]; \
    rtt = *(const uint4*)(ob + ((size_t)b * NTB + scan2nat((cc) * 64 + si, dir)) * DM + 512 + h * 128 + vs * 64 + 8 * sp); \
    _Pragma("unroll") for (int k = 0; k < 5; ++k) { \
      const int nn = nlo_ - 2 + k; \
      const bool ok = (nn >= lo_ && nn < hi_); \
      const bf16_t* rr = proj + ((size_t)b * NTB + (ok ? nn : nlo_)) * OD_IN; \
      const uint4 a_ = *(const uint4*)(rr + 2560 + h * 128 + 8 * cg); \
      const uint4 b_ = *(const uint4*)(rr + 3072 + h * 128 + 8 * cg); \
      const uint2 c_ = *(const uint2*)(rr + 3584 + h * 128 + vs * 64 + 4 * cg); \
      rq[k] = ok ? a_ : make_uint4(0u, 0u, 0u, 0u); rk[k] = ok ? b_ : make_uint4(0u, 0u, 0u, 0u); rv[k] = ok ? c_ : make_uint2(0u, 0u); } } while (0)
  GDN_LOAD(0);
  __syncthreads();
  for (int c = 0; c < 68; ++c) {
    float gl;
    {
      gl = rgl;
      const float gc0 = rg0, gc1 = rg1, bi0 = rb0, bi1 = rb1;
      *(uint4*)(Tm + si * 72 + 8 * sp) = rtt;
      const int i0 = 2 * tp, i1 = 2 * tp + 1;
      const float eg0 = __expf(gc0), eg1 = __expf(gc1), kb0 = bi0 * eg0, kb1 = bi1 * eg1;
      {
        float aL[8], aH[8];
#pragma unroll
        for (int j = 0; j < 8; ++j) { aL[j] = 0.f; aH[j] = 0.f; }
#pragma unroll
        for (int k = 0; k < 5; ++k) {
          float x[8]; unpack8(rq[k], x);
          if (k < 4) {
#pragma unroll
            for (int j = 0; j < 8; ++j) aL[j] += CW[k * 320 + 8 * cg + j] * x[j];
          }
          if (k > 0) {
#pragma unroll
            for (int j = 0; j < 8; ++j) aH[j] += CW[(k - 1) * 320 + 8 * cg + j] * x[j];
          }
        }
        float sL = 0.f, sH = 0.f;
#pragma unroll
        for (int j = 0; j < 8; ++j) { aL[j] = siluf_(aL[j]); aH[j] = siluf_(aH[j]); sL += aL[j] * aL[j]; sH += aH[j] * aH[j]; }
        sL = row16_sum(sL); sH = row16_sum(sH);
        const float rL = rsqrtf(sL + 1e-6f) * 0.08838834764831845f, rH = rsqrtf(sH + 1e-6f) * 0.08838834764831845f;
        float q0[8], q1[8];
#pragma unroll
        for (int j = 0; j < 8; ++j) { const float a_ = aL[j] * rL, b_ = aH[j] * rH; q0[j] = dir ? b_ : a_; q1[j] = dir ? a_ : b_; }
        *(uint4*)(Qs + i0 * 136 + 8 * cg) = pack8(q0); *(uint4*)(Qs + i1 * 136 + 8 * cg) = pack8(q1);
#pragma unroll
        for (int j = 0; j < 8; ++j) { q0[j] *= eg0; q1[j] *= eg1; }
        *(uint4*)(PQ + i0 * 200 + 64 + 8 * cg) = pack8(q0); *(uint4*)(PQ + i1 * 200 + 64 + 8 * cg) = pack8(q1);
      }
      asm volatile("" ::: "memory");
      {
        float aL[8], aH[8];
#pragma unroll
        for (int j = 0; j < 8; ++j) { aL[j] = 0.f; aH[j] = 0.f; }
#pragma unroll
        for (int k = 0; k < 5; ++k) {
          float x[8]; unpack8(rk[k], x);
          if (k < 4) {
#pragma unroll
            for (int j = 0; j < 8; ++j) aL[j] += CW[k * 320 + 128 + 8 * cg + j] * x[j];
          }
          if (k > 0) {
#pragma unroll
            for (int j = 0; j < 8; ++j) aH[j] += CW[(k - 1) * 320 + 128 + 8 * cg + j] * x[j];
          }
        }
        float sL = 0.f, sH = 0.f;
#pragma unroll
        for (int j = 0; j < 8; ++j) { aL[j] = siluf_(aL[j]); aH[j] = siluf_(aH[j]); sL += aL[j] * aL[j]; sH += aH[j] * aH[j]; }
        sL = row16_sum(sL); sH = row16_sum(sH);
        const float rL = rsqrtf(sL + 1e-6f), rH = rsqrtf(sH + 1e-6f);
        float k0[8], k1[8];
#pragma unroll
        for (int j = 0; j < 8; ++j) { const float a_ = aL[j] * rL, b_ = aH[j] * rH; k0[j] = dir ? b_ : a_; k1[j] = dir ? a_ : b_; }
        *(uint4*)(Ks + i0 * 136 + 8 * cg) = pack8(k0); *(uint4*)(Ks + i1 * 136 + 8 * cg) = pack8(k1);
#pragma unroll
        for (int j = 0; j < 8; ++j) *(unsigned*)(KT + (8 * cg + j) * 72 + i0) = pack2(k0[j], k1[j]);
#pragma unroll
        for (int j = 0; j < 8; ++j) { k0[j] *= kb0; k1[j] *= kb1; }
        *(uint4*)(Ks2 + i0 * 136 + 8 * cg) = pack8(k0); *(uint4*)(Ks2 + i1 * 136 + 8 * cg) = pack8(k1);
      }
      asm volatile("" ::: "memory");
      {
        float aL[4], aH[4];
#pragma unroll
        for (int j = 0; j < 4; ++j) { aL[j] = 0.f; aH[j] = 0.f; }
#pragma unroll
        for (int k = 0; k < 5; ++k) {
          float x[4];
          x[0] = __uint_as_float(rv[k].x << 16); x[1] = __uint_as_float(rv[k].x & 0xffff0000u);
          x[2] = __uint_as_float(rv[k].y << 16); x[3] = __uint_as_float(rv[k].y & 0xffff0000u);
          if (k < 4) {
#pragma unroll
            for (int j = 0; j < 4; ++j) aL[j] += CW[k * 320 + 256 + 4 * cg + j] * x[j];
          }
          if (k > 0) {
#pragma unroll
            for (int j = 0; j < 4; ++j) aH[j] += CW[(k - 1) * 320 + 256 + 4 * cg + j] * x[j];
          }
        }
#pragma unroll
        for (int j = 0; j < 4; ++j) {
          const float a_ = siluf_(aL[j]), b_ = siluf_(aH[j]);
          *(unsigned*)(VB + (4 * cg + j) * 200 + i0) = pack2((dir ? b_ : a_) * bi0, (dir ? a_ : b_) * bi1);
        }
      }
      asm volatile("" ::: "memory");
      if (c + 1 < 68) GDN_LOAD(c + 1);
      if (cg == 0) { gcs[i0] = gc0; gcs[i1] = gc1; e2[i0] = __expf(gl - gc0); e2[i1] = __expf(gl - gc1); }
    }
    __syncthreads();
    {
      f32x4 a2[1][2];
      a2[0][0] = (f32x4){0.f, 0.f, 0.f, 0.f}; a2[0][1] = a2[0][0];
      lds_mma<1, 2, 128>(Qs, 136, Ks, 136, m0, n0, a2, lane);
#pragma unroll
      for (int j = 0; j < 2; ++j)
#pragma unroll
        for (int r = 0; r < 4; ++r) {
          const int i = m0 + quad * 4 + r, jj = n0 + j * 16 + l15;
          PQ[i * 200 + jj] = f2bf((i >= jj) ? a2[0][j][r] * __expf(gcs[i] - gcs[jj]) : 0.f);
        }
      f32x4 pa[1][2];
      pa[0][0] = (f32x4){0.f, 0.f, 0.f, 0.f}; pa[0][1] = pa[0][0];
      lds_mma<1, 2, 128>(Ks2, 136, VB + 64, 200, m0, n0, pa, lane);
#pragma unroll
      for (int j = 0; j < 2; ++j) {
        const int v = n0 + j * 16 + l15, j0 = m0 + quad * 4;
        const uint2 vb = *(const uint2*)(VB + v * 200 + j0);
        const float v0 = __uint_as_float(vb.x << 16), v1 = __uint_as_float(vb.x & 0xffff0000u);
        const float v2 = __uint_as_float(vb.y << 16), v3 = __uint_as_float(vb.y & 0xffff0000u);
        uint2 o; o.x = pack2(v0 - pa[0][j][0], v1 - pa[0][j][1]); o.y = pack2(v2 - pa[0][j][2], v3 - pa[0][j][3]);
        *(uint2*)(RT + v * 72 + j0) = o;
      }
    }
    __syncthreads();
    {
      f32x4 acc[1][2]; acc[0][0] = (f32x4){0.f, 0.f, 0.f, 0.f}; acc[0][1] = acc[0][0];
      lds_mma<1, 2, 64>(Tm, 72, RT, 72, m0, n0, acc, lane);
#pragma unroll
      for (int j = 0; j < 2; ++j) {
        const int v = n0 + j * 16 + l15, i0 = m0 + quad * 4;
        uint2 o; o.x = pack2(acc[0][j][0], acc[0][j][1]); o.y = pack2(acc[0][j][2], acc[0][j][3]);
        *(uint2*)(VB + v * 200 + i0) = o;
        uint2 o2; o2.x = pack2(acc[0][j][0] * e2[i0], acc[0][j][1] * e2[i0 + 1]); o2.y = pack2(acc[0][j][2] * e2[i0 + 2], acc[0][j][3] * e2[i0 + 3]);
        *(uint2*)(V2T + v * 72 + i0) = o2;
      }
    }
    __syncthreads();
    {
      f32x4 acc[1][2]; acc[0][0] = (f32x4){0.f, 0.f, 0.f, 0.f}; acc[0][1] = acc[0][0];
      lds_mma<1, 2, 192>(PQ, 200, VB, 200, m0, n0, acc, lane);
#pragma unroll
      for (int r = 0; r < 4; ++r) {
        const int i = m0 + quad * 4 + r;
        const int n = scan2nat(c * 64 + i, dir);
        bf16_t* orow = ob + ((size_t)b * NTB + n) * DM + 512 + h * 128 + vs * 64 + n0 + l15;
        orow[0] = f2bf(acc[0][0][r]); orow[16] = f2bf(acc[0][1][r]);
      }
    }
    {
      const float ge = __expf(gl);
#pragma unroll
      for (int j = 0; j < 4; ++j) S[0][j] *= ge;
      lds_mma<1, 4, 64>(KT, 72, V2T, 72, wave * 16, 0, S, lane);
    }
    __syncthreads();
#pragma unroll
    for (int j = 0; j < 4; ++j) {
      const int v = j * 16 + l15, d = wave * 16 + quad * 4;
      uint2 uu; uu.x = pack2(S[0][j][0], S[0][j][1]); uu.y = pack2(S[0][j][2], S[0][j][3]);
      *(uint2*)(VB + v * 200 + 64 + d) = uu;
    }
  }
  __syncthreads();
}

#ifndef NAIVE_EVEN
#define NAIVE_EVEN 0
#endif
#ifndef NAIVE_ODD
#define NAIVE_ODD 0
#endif
__device__ __forceinline__ void chains_phase(const Params& p, int layer, char* lds) {
  const int wave = threadIdx.x >> 6;
  float* wl = (float*)(lds + wave * 2048);
  const int item = blockIdx.x + gridDim.x * wave;
  if (layer & 1) {
#if NAIVE_ODD
    if (item >= 512) { chain_idle(); return; }
    if (item < 256) chain_gla(p, layer, item, wl); else chain_gdn(p, layer, item - 256, wl);
#else
    for (int it = blockIdx.x; it < 256; it += gridDim.x) {
      if (it < 128) cgla(p, layer, it, lds); else cgdn(p, layer, it - 128, lds);
    }
#endif
  } else {
#if NAIVE_EVEN
    if (item >= 384) { chain_idle(); return; }
    if (item < 128) chain_ret(p, layer, item, wl); else chain_lru(p, layer, item - 128, wl);
#else
    for (int it = blockIdx.x; it < 256; it += gridDim.x) {
      if (it < 128) cret(p, layer, it, lds); else clru(p, layer, it - 128, lds);
    }
#endif
  }
}

__device__ __forceinline__ void combine_phase(const Params& p, int layer) {
  const int tid = otid(), lane = tid & 63, wave = __builtin_amdgcn_readfirstlane(tid >> 6);
  const int odd = layer & 1;
  const bf16_t* proj = (const bf16_t*)(p.ws + OFF_BIG);
  bf16_t* zf = (bf16_t*)(p.ws + OFF_BUFB);
  const bf16_t* zr = (const bf16_t*)(p.ws + OFF_BUFA);
  const int ldp = odd ? OD_IN : EV_IN;
#pragma unroll 1
  for (int u = blockIdx.x * 8 + wave; u < TT * 2; u += gridDim.x * 8) {
    const int g = u >> 1, hh = u & 1;
    const int c = hh * 512 + lane * 8;
    int gcol;
    if (!odd) gcol = hh ? (2048 + (c - 512)) : (512 + c);
    else gcol = hh ? (4096 + (c - 512)) : (2048 + c);
    const uint4 a4 = *(const uint4*)(zf + (size_t)g * DM + c);
    const uint4 b4 = *(const uint4*)(zr + (size_t)g * DM + c);
    const uint4 g4 = *(const uint4*)(proj + (size_t)g * ldp + gcol);
    float o[8], gt[8], y[8];
    unpack8(a4, o); unpack8(b4, y); unpack8(g4, gt);
#pragma unroll
    for (int j = 0; j < 8; ++j) o[j] += y[j];
    if (!odd && hh == 0) {
#pragma unroll
      for (int j = 0; j < 8; ++j) y[j] = o[j] * gelu_tanh(gt[j]);
    } else {
      if (!odd) {
        float s = 0.f;
#pragma unroll
        for (int j = 0; j < 8; ++j) s += o[j];
        s = row16_sum(s);
        const float mean = s * (1.f / 128.f);
#pragma unroll
        for (int j = 0; j < 8; ++j) o[j] -= mean;
      }
      float ss = 0.f;
#pragma unroll
      for (int j = 0; j < 8; ++j) ss += o[j] * o[j];
      ss = row16_sum(ss);
      const float rs = rsqrtf(ss * (1.f / 128.f) + 1e-6f);
#pragma unroll
      for (int j = 0; j < 8; ++j) y[j] = o[j] * rs * siluf_(gt[j]);
    }
    *(uint4*)(zf + (size_t)g * DM + c) = pack8(y);
  }
}

#define XB_TMO      128
#define XB_XCNT(j)  (256  + 64 * (j))
#define XB_XSUB(j)  (1280 + 64 * (j))
#define XB_XGEN(j)  (2304 + 64 * (j))
#define XB_TOP      3328
#define XB_TOPGEN   3392
#define XCD_BAR_WORDS 3456
#define XB_SPIN_CAP (1u << 18)
#define LAS __attribute__((address_space(3)))
#define OFF_BAR 508755968ull
__device__ __forceinline__ unsigned xb_ld(unsigned* p)              { return __hip_atomic_load(p, __ATOMIC_RELAXED, __HIP_MEMORY_SCOPE_AGENT); }
__device__ __forceinline__ unsigned xb_add(unsigned* p, unsigned v) { return __hip_atomic_fetch_add(p, v, __ATOMIC_RELAXED, __HIP_MEMORY_SCOPE_AGENT); }
__device__ __forceinline__ unsigned xb_xcc_id() { return (unsigned)__builtin_amdgcn_s_getreg((3 << 11) | 20) & 0xFu; }
#define XB_SPIN(cond, bar) do { unsigned _sp = 0; while (cond) { __builtin_amdgcn_s_sleep(1); \
    if ((++_sp & 255u) == 0u) { if (xb_ld(&(bar)[XB_TMO])) break; if (_sp > XB_SPIN_CAP) { atomicAdd(&(bar)[XB_TMO], 1u); break; } } } } while (0)
struct XcdBarrier { unsigned* bar; unsigned x; volatile LAS unsigned* st; };
__device__ __forceinline__ XcdBarrier xcd_barrier_post(unsigned* bar, volatile LAS unsigned* st) {
  XcdBarrier b; b.bar = bar; b.x = xb_xcc_id(); b.st = st;
  if (threadIdx.x == 0) (void)xb_add(&bar[XB_XCNT(b.x)], 1u);
  return b;
}
__device__ __forceinline__ void xcd_barrier_complete(unsigned* bar, unsigned x, unsigned& nloc, unsigned& nx) {
  const unsigned G = gridDim.x * gridDim.y * gridDim.z;
  unsigned sum, cnt, mine, sp = 0u;
  for (;;) {
    sum = 0u; cnt = 0u; mine = 0u;
#pragma unroll
    for (unsigned j = 0; j < 16; ++j) { const unsigned c = xb_ld(&bar[XB_XCNT(j)]); sum += c; cnt += (c > 0u) ? 1u : 0u; mine = (j == x) ? c : mine; }
    if (sum == G) break;
    __builtin_amdgcn_s_sleep(1);
    if ((++sp & 255u) == 0u) { if (xb_ld(&bar[XB_TMO])) break; if (sp > XB_SPIN_CAP) { atomicAdd(&bar[XB_TMO], 1u); break; } }
  }
  nloc = mine > 0u ? mine : 1u; nx = cnt > 0u ? cnt : 1u;
}
__device__ __forceinline__ void xcd_barrier_(const XcdBarrier& b) {
  asm volatile("s_waitcnt vmcnt(0)" ::: "memory");
  __syncthreads();
  if (threadIdx.x == 0) {
    unsigned* bar = b.bar;
    __builtin_amdgcn_s_waitcnt(0);
    unsigned nloc = b.st[0], nx = b.st[1];
    if (nloc == 0u) { xcd_barrier_complete(bar, b.x, nloc, nx); b.st[0] = nloc; b.st[1] = nx; }
    const unsigned old = xb_add(&bar[XB_XSUB(b.x)], 1u);
    const unsigned gen = old / nloc;
    if (old + 1u == (gen + 1u) * nloc) {
      __builtin_amdgcn_fence(__ATOMIC_RELEASE, "agent");
      asm volatile("s_waitcnt vmcnt(0)" ::: "memory");
      const unsigned og = xb_add(&bar[XB_TOP], 1u);
      const unsigned tg = og / nx;
      if (og + 1u == (tg + 1u) * nx) xb_add(&bar[XB_TOPGEN], 1u);
      else XB_SPIN(xb_ld(&bar[XB_TOPGEN]) == tg, bar);
      __builtin_amdgcn_fence(__ATOMIC_ACQUIRE, "agent");
      xb_add(&bar[XB_XGEN(b.x)], 1u);
      asm volatile("s_waitcnt vmcnt(0)" ::: "memory");
    } else {
      XB_SPIN(xb_ld(&bar[XB_XGEN(b.x)]) == gen, bar);
      __builtin_amdgcn_fence(__ATOMIC_ACQUIRE, "agent");
      asm volatile("s_waitcnt vmcnt(0)" ::: "memory");
    }
  }
  __syncthreads();
}

__device__ __forceinline__ void xcd_barrier(const Params& p, char* lds) {
  XcdBarrier b; b.bar = (unsigned*)(p.ws + OFF_BAR); b.x = xb_xcc_id(); b.st = (volatile LAS unsigned*)(LAS char*)(lds + LDS_BYTES - 16);
  xcd_barrier_(b);
}

__global__ void __launch_bounds__(NTHREADS) mega(Params p) {
  extern __shared__ __attribute__((aligned(16))) char lds[];
  cg::grid_group grid = cg::this_grid();
  volatile LAS unsigned* xst = (volatile LAS unsigned*)(LAS char*)(lds + LDS_BYTES - 16);
  if (threadIdx.x == 0) { xst[0] = 0u; xst[1] = 0u; }
  __syncthreads();
  (void)xcd_barrier_post((unsigned*)(p.ws + OFF_BAR), xst);
  phase0(p, lds);
  grid.sync();
  bf16_t* bufA = (bf16_t*)(p.ws + OFF_BUFA);
  bf16_t* bufB = (bf16_t*)(p.ws + OFF_BUFB);
  bf16_t* big = (bf16_t*)(p.ws + OFF_BIG);
  bf16_t* wb = (bf16_t*)(p.ws + OFF_W);
  for (int layer = 0; layer < 4; ++layer) {
    const float* mod = (const float*)(p.ws + OFF_MOD) + (size_t)layer * 9 * 6144;
    const int nin = (layer & 1) ? OD_IN : EV_IN;
    norm_phase(p, layer, 0);
    convert_weights(p, layer, lds);
    xcd_barrier(p, lds);
    gemm_phase<0>(p, bufA, DM, wb + WO_IN, nin, 1024, big, nin, nullptr, lds);
    xcd_barrier(p, lds);
    if (layer & 1) { gdn_prep_phase(p, layer, lds); xcd_barrier(p, lds); }
    chains_phase(p, layer, lds);
    xcd_barrier(p, lds);
    combine_phase(p, layer);
    xcd_barrier(p, lds);
    gemm_phase<2>(p, bufB, DM, wb + WO_OUT, 1024, 1024, nullptr, 0, mod + 2 * 1024, lds, layer == 0);
    xcd_barrier(p, lds);
    norm_phase(p, layer, 1);
    xcd_barrier(p, lds);
    gemm_phase<1>(p, bufA, DM, wb + WO_W1, DFF, 1024, big, DFF, nullptr, lds);
    xcd_barrier(p, lds);
    gemm_phase<2>(p, big, DFF, wb + WO_W2, 1024, 4096, nullptr, 0, mod + 5 * 1024, lds);
    xcd_barrier(p, lds);
  }
  final_norm(p);
}

extern "C" void kernel_launch(void* const* d_in, const int* in_sizes, int n_in, void* d_out, int out_size, void* d_ws, size_t ws_size,
                              hipStream_t stream) {
  static int grid_blocks = 0;
  if (!grid_blocks) {
    int dev = 0, cus = 0, per_cu = 0;
    hipGetDevice(&dev);
    hipDeviceGetAttribute(&cus, hipDeviceAttributeMultiprocessorCount, dev);
    hipFuncSetAttribute((const void*)mega, hipFuncAttributeMaxDynamicSharedMemorySize, LDS_BYTES);
    hipOccupancyMaxActiveBlocksPerMultiprocessor(&per_cu, (const void*)mega, NTHREADS, LDS_BYTES);
    if (per_cu < 1) per_cu = 1;
    if (per_cu > 1) per_cu = 1;
    if (cus < 1) cus = 256;
    grid_blocks = cus * per_cu;
  }
  Params p{};
  for (int i = 0; i < 26; ++i) p.in[i] = (const float*)d_in[i];
  p.out = (float*)d_out;
  p.ws = (unsigned char*)d_ws;
  (void)hipMemsetAsync((char*)d_ws + OFF_BAR, 0, XCD_BAR_WORDS * 4, stream);
  void* args[] = {&p};
  hipError_t e = hipLaunchCooperativeKernel((const void*)mega, dim3(grid_blocks), dim3(NTHREADS), args, LDS_BYTES, stream);
  if (e != hipSuccess) fprintf(stderr, "cooperative launch failed: %s (grid %d)\n", hipGetErrorString(e), grid_blocks);
}
```

```cpp
#include <hip/hip_runtime.h>
#include <hip/hip_cooperative_groups.h>
#include <cstdio>
namespace cg = cooperative_groups;

typedef unsigned short bf16_t;
using bf16x8 = __attribute__((ext_vector_type(8))) short;
using f32x4 = __attribute__((ext_vector_type(4))) float;

#define NTB 4352
#define TT 34816
#define DM 1024
#define DFF 4096
#define EV_IN 2560
#define OD_IN 4624
#define NTHREADS 512
#define LDS_BYTES 157696

#define OFF_XC   0ull
#define OFF_MOD  8388608ull
#define OFF_ROPE 9437184ull
#define OFF_W    10485760ull
#define OFF_BUFA 41943040ull
#define OFF_BUFB 113246208ull
#define OFF_BIG  184549376ull
#define WO_IN   0
#define WO_OUT  4849664
#define WO_W1   5898240
#define WO_W2   10092544

struct Params {
  const float* in[26];
  float* out;
  unsigned char* ws;
};

__device__ __forceinline__ float bf2f(bf16_t u) { return __uint_as_float(((unsigned)u) << 16); }
typedef __bf16 bf16x2_t __attribute__((ext_vector_type(2)));
__device__ __forceinline__ bf16_t f2bf(float f) { return __builtin_bit_cast(unsigned short, (__bf16)f); }
__device__ __forceinline__ unsigned pack2(float a, float b) { bf16x2_t v = {(__bf16)a, (__bf16)b}; return __builtin_bit_cast(unsigned, v); }
__device__ __forceinline__ float frcp_(float x) { return __builtin_amdgcn_rcpf(x); }
__device__ __forceinline__ float sigmoidf_(float x) { return frcp_(1.f + __expf(-x)); }
__device__ __forceinline__ float siluf_(float x) { return x * sigmoidf_(x); }
__device__ __forceinline__ float gelu_tanh(float x) {
  const float u = 0.7978845608028654f * (x + 0.044715f * x * x * x);
  const float t = 1.f - 2.f * frcp_(1.f + __expf(2.f * u));
  return 0.5f * x * (1.f + t);
}
__device__ __forceinline__ float softplusf_(float x) { return fmaxf(x, 0.f) + __logf(1.f + __expf(-fabsf(x))); }
template <int CTRL> __device__ __forceinline__ float dppf(float v) {
  return __int_as_float(__builtin_amdgcn_update_dpp(0, __float_as_int(v), CTRL, 0xF, 0xF, true));
}
__device__ __forceinline__ float quad_sum(float v) { v += dppf<0xB1>(v); v += dppf<0x4E>(v); return v; }
__device__ __forceinline__ float oct_sum(float v) { v = quad_sum(v); v += dppf<0x141>(v); return v; }
__device__ __forceinline__ float row16_sum(float v) { v = oct_sum(v); v += dppf<0x140>(v); return v; }
__device__ __forceinline__ float wave_sum(float v) {
  v = row16_sum(v);
  return __builtin_amdgcn_readlane(v, 0) + __builtin_amdgcn_readlane(v, 16) + __builtin_amdgcn_readlane(v, 32) + __builtin_amdgcn_readlane(v, 48);
}
__device__ __forceinline__ float wave_incl_scan(float v) {
  v += __int_as_float(__builtin_amdgcn_update_dpp(0, __float_as_int(v), 0x111, 0xF, 0xF, false));
  v += __int_as_float(__builtin_amdgcn_update_dpp(0, __float_as_int(v), 0x112, 0xF, 0xF, false));
  v += __int_as_float(__builtin_amdgcn_update_dpp(0, __float_as_int(v), 0x114, 0xF, 0xF, false));
  v += __int_as_float(__builtin_amdgcn_update_dpp(0, __float_as_int(v), 0x118, 0xF, 0xF, false));
  v += __int_as_float(__builtin_amdgcn_update_dpp(0, __float_as_int(v), 0x142, 0xA, 0xF, false));
  v += __int_as_float(__builtin_amdgcn_update_dpp(0, __float_as_int(v), 0x143, 0xC, 0xF, false));
  return v;
}
__device__ __forceinline__ int otid() { int t = threadIdx.x; asm volatile("" : "+v"(t)); return t; }
__device__ __forceinline__ float* xrow(const Params& p, int g) {
  int b = g / NTB, n = g - b * NTB;
  return n < 256 ? ((float*)(p.ws + OFF_XC) + (size_t)(b * 256 + n) * DM) : (p.out + (size_t)(b * 4096 + (n - 256)) * DM);
}
__device__ __forceinline__ const float* xrow_src(const Params& p, int g, bool first) {
  int b = g / NTB, n = g - b * NTB;
  if (first) return n < 256 ? (p.in[2] + (size_t)(b * 256 + n) * DM) : (p.in[0] + (size_t)(b * 4096 + (n - 256)) * DM);
  return n < 256 ? ((const float*)(p.ws + OFF_XC) + (size_t)(b * 256 + n) * DM) : (p.out + (size_t)(b * 4096 + (n - 256)) * DM);
}
__device__ __forceinline__ int scan2nat(int pos, int dir) { return dir ? (pos < 256 ? 255 - pos : 4607 - pos) : pos; }

__device__ __forceinline__ void phase0(const Params& p, char* lds) {
  const int tid = threadIdx.x, lane = tid & 63, wave = tid >> 6;
  float* sv = (float*)lds;
  float* red = (float*)(lds + 36864);
  const float* c = p.in[1];
  const float* cctx = p.in[3];
  for (int i = tid; i < 9 * 1024; i += NTHREADS) {
    float v = (i < 8192) ? c[i] : cctx[i - 8192];
    sv[i] = siluf_(v);
  }
  __syncthreads();
  float* mod = (float*)(p.ws + OFF_MOD);
  for (int it = blockIdx.x; it < 4 * 96; it += gridDim.x) {
    int l = it / 96, cg_ = it % 96;
    int col = cg_ * 64 + lane;
    const float* W = p.in[4] + (size_t)l * 1024 * 6144 + col;
    float acc[9];
#pragma unroll
    for (int r = 0; r < 9; ++r) acc[r] = 0.f;
#pragma unroll 8
    for (int k = wave * 128; k < wave * 128 + 128; ++k) {
      float w = W[(size_t)k * 6144];
#pragma unroll
      for (int r = 0; r < 9; ++r) acc[r] += sv[r * 1024 + k] * w;
    }
#pragma unroll
    for (int r = 0; r < 9; ++r) red[(wave * 9 + r) * 64 + lane] = acc[r];
    __syncthreads();
    for (int i = tid; i < 9 * 64; i += NTHREADS) {
      int r = i / 64, cc = i % 64;
      float s = 0.f;
#pragma unroll
      for (int w = 0; w < 8; ++w) s += red[(w * 9 + r) * 64 + cc];
      int colo = cg_ * 64 + cc;
      mod[((size_t)l * 9 + r) * 6144 + colo] = s + p.in[5][l * 6144 + colo];
    }
    __syncthreads();
  }
  const size_t gt = (size_t)blockIdx.x * NTHREADS + tid, gs = (size_t)gridDim.x * NTHREADS;
  float* ct = (float*)(p.ws + OFF_ROPE); float* st = ct + 4096 * 32;
  for (size_t i = gt; i < 4096 * 32; i += gs) {
    int t = (int)(i >> 5), pp = (int)(i & 31);
    int f = pp & 15;
    float inv = powf(10000.f, -(float)f / 16.f);
    float pos = (pp < 16) ? (float)(t >> 6) : (float)(t & 63);
    float ang = pos * inv;
    ct[i] = cosf(ang); st[i] = sinf(ang);
  }
}

__device__ __forceinline__ void norm_phase(const Params& p, int layer, int which) {
  const int tid = otid(), lane = tid & 63, wave = tid >> 6;
  const float* g = (which ? p.in[7] : p.in[6]) + layer * DM;
  const float* mod = (const float*)(p.ws + OFF_MOD) + (size_t)layer * 9 * 6144;
  bf16_t* dst = (bf16_t*)(p.ws + OFF_BUFA);
  for (int row = blockIdx.x * 8 + wave; row < TT; row += gridDim.x * 8) {
    int b = row / NTB, n = row - b * NTB;
    int r = n < 256 ? 8 : b;
    const float* x = xrow_src(p, row, layer == 0 && which == 0);
    const float* sh = mod + (size_t)r * 6144 + (which ? 3 : 0) * 1024;
    const float* sc = sh + 1024;
    float4 v[4]; float ss = 0.f;
#pragma unroll
    for (int i = 0; i < 4; ++i) { v[i] = *(const float4*)(x + i * 256 + lane * 4); ss += v[i].x * v[i].x + v[i].y * v[i].y + v[i].z * v[i].z + v[i].w * v[i].w; }
    ss = wave_sum(ss);
    float rstd = rsqrtf(ss * (1.f / 1024.f) + 1e-6f);
#pragma unroll
    for (int i = 0; i < 4; ++i) {
      int cidx = i * 256 + lane * 4;
      float4 gg = *(const float4*)(g + cidx), s1 = *(const float4*)(sc + cidx), s0 = *(const float4*)(sh + cidx);
      float a0 = v[i].x * rstd * gg.x * (1.f + s1.x) + s0.x;
      float a1 = v[i].y * rstd * gg.y * (1.f + s1.y) + s0.y;
      float a2 = v[i].z * rstd * gg.z * (1.f + s1.z) + s0.z;
      float a3 = v[i].w * rstd * gg.w * (1.f + s1.w) + s0.w;
      uint2 o; o.x = pack2(a0, a1); o.y = pack2(a2, a3);
      *(uint2*)(dst + (size_t)row * DM + cidx) = o;
    }
  }
}

__device__ __forceinline__ void final_norm(const Params& p) {
  const int tid = otid(), lane = tid & 63, wave = tid >> 6;
  const float* g = p.in[25];
  for (int row = blockIdx.x * 8 + wave; row < 8 * 4096; row += gridDim.x * 8) {
    float* x = p.out + (size_t)row * DM;
    float4 v[4]; float ss = 0.f;
#pragma unroll
    for (int i = 0; i < 4; ++i) { v[i] = *(const float4*)(x + i * 256 + lane * 4); ss += v[i].x * v[i].x + v[i].y * v[i].y + v[i].z * v[i].z + v[i].w * v[i].w; }
    ss = wave_sum(ss);
    float rstd = rsqrtf(ss * (1.f / 1024.f) + 1e-6f);
#pragma unroll
    for (int i = 0; i < 4; ++i) {
      int cidx = i * 256 + lane * 4;
      float4 gg = *(const float4*)(g + cidx);
      float4 o; o.x = v[i].x * rstd * gg.x; o.y = v[i].y * rstd * gg.y; o.z = v[i].z * rstd * gg.z; o.w = v[i].w * rstd * gg.w;
      *(float4*)(x + cidx) = o;
    }
  }
}

__device__ __forceinline__ void convert_weights(const Params& p, int layer, char* lds) {
  const int tid = otid();
  bf16_t* Tl = (bf16_t*)lds;
  bf16_t* wbase = (bf16_t*)(p.ws + OFF_W);
  const int odd = layer & 1;
  const float* srcs[4]; int Ks[4], Ns[4]; bf16_t* dsts[4]; int cnt[4];
  srcs[0] = odd ? p.in[20] + (size_t)(layer >> 1) * 1024 * OD_IN : p.in[11] + (size_t)(layer >> 1) * 1024 * EV_IN;
  Ks[0] = 1024; Ns[0] = odd ? OD_IN : EV_IN; dsts[0] = wbase + WO_IN;
  srcs[1] = p.in[8] + (size_t)layer * 1024 * 1024; Ks[1] = 1024; Ns[1] = 1024; dsts[1] = wbase + WO_OUT;
  srcs[2] = p.in[9] + (size_t)layer * 1024 * 4096; Ks[2] = 1024; Ns[2] = 4096; dsts[2] = wbase + WO_W1;
  srcs[3] = p.in[10] + (size_t)layer * 4096 * 1024; Ks[3] = 4096; Ns[3] = 1024; dsts[3] = wbase + WO_W2;
  int total = 0;
#pragma unroll
  for (int i = 0; i < 4; ++i) { cnt[i] = (Ks[i] / 64) * ((Ns[i] + 63) / 64); total += cnt[i]; }
  for (int it = blockIdx.x; it < total; it += gridDim.x) {
    int r = it, mi = 0;
    if (r >= cnt[0]) { r -= cnt[0]; mi = 1; if (r >= cnt[1]) { r -= cnt[1]; mi = 2; if (r >= cnt[2]) { r -= cnt[2]; mi = 3; } } }
    const float* W = mi == 0 ? srcs[0] : mi == 1 ? srcs[1] : mi == 2 ? srcs[2] : srcs[3];
    const int K = mi == 3 ? 4096 : 1024;
    const int N = mi == 0 ? Ns[0] : mi == 1 ? 1024 : mi == 2 ? 4096 : 1024;
    bf16_t* D = mi == 0 ? dsts[0] : mi == 1 ? dsts[1] : mi == 2 ? dsts[2] : dsts[3];
    const int ntn = (N + 63) / 64;
    const int kt = r / ntn, nt = r % ntn;
    const int k0 = kt * 64, n0 = nt * 64;
    {
      const int rr = tid >> 4, c4 = (tid & 15) * 4;
#pragma unroll
      for (int ps = 0; ps < 2; ++ps) {
        int k = k0 + rr + 32 * ps, n = n0 + c4;
        float4 v = make_float4(0.f, 0.f, 0.f, 0.f);
        if (n < N) v = *(const float4*)(W + (size_t)k * N + n);
        Tl[(c4 + 0) * 72 + rr + 32 * ps] = f2bf(v.x);
        Tl[(c4 + 1) * 72 + rr + 32 * ps] = f2bf(v.y);
        Tl[(c4 + 2) * 72 + rr + 32 * ps] = f2bf(v.z);
        Tl[(c4 + 3) * 72 + rr + 32 * ps] = f2bf(v.w);
      }
    }
    __syncthreads();
    {
      const int nr = tid >> 3, kc = tid & 7;
      if (n0 + nr < N) *(uint4*)(D + (size_t)(n0 + nr) * K + k0 + kc * 8) = *(const uint4*)(Tl + nr * 72 + kc * 8);
    }
    __syncthreads();
  }
}

template <int KS> __device__ __forceinline__ int lds_byte(int r, int c) {
  int st = (r >> 4) * KS + (c >> 5), ob = (r & 15) * 64 + (c & 31) * 2;
  return st * 1024 + (ob ^ (((ob >> 9) & 1) << 5));
}
template <int KS> __device__ __forceinline__ void stage_rc(int b, int& R, int& C) {
  int st = b >> 10, sb = b & 1023, swz = sb ^ (((sb >> 9) & 1) << 5);
  R = (st / KS) * 16 + swz / 64;
  C = (st % KS) * 32 + (swz % 64) / 2;
}
#define WAIT_V0() asm volatile("s_waitcnt vmcnt(0)" ::: "memory")

template <int EPI>
__device__ __forceinline__ void gemm_phase(const Params& p, const bf16_t* __restrict__ A, int lda_unused, const bf16_t* __restrict__ Bt, int N, int K,
                           bf16_t* outb, int ldo, const float* modv, char* lds, bool first = false) {
  constexpr int KS = 2, BK = 64, TA_B = 272 * BK * 2, TB_B = 256 * BK * 2, STAGE_B = TA_B + TB_B, NPASS = 9;
  const int tid = otid(), lane = tid & 63, wid = __builtin_amdgcn_readfirstlane(tid >> 6);
  const int fr = lane & 15, fq = lane >> 4;
  const int wr = wid >> 2, wc = wid & 3, rbase = wr * 144;
  const int nM = TT / 272, nN = (N + 255) / 256, nwg = nM * nN;
  const int nt = K / BK;
  int sR[NPASS], sC[NPASS];
#pragma unroll
  for (int i = 0; i < NPASS; ++i) {
    const int s = i * 8 + wid;
    const int sl = s < 34 ? s : s - 34;
    stage_rc<KS>(sl * 1024 + lane * 16, sR[i], sC[i]);
  }
  int so[NPASS];
  const bf16_t* Ab = A;
  int nbrow = 0, nbcol = 0;
#define TILE_COORDS(w) do { int wgid = (w); \
      { int q = nwg / 8, r = nwg % 8, xcd = wgid % 8, off = wgid / 8; \
        wgid = (xcd < r ? xcd * (q + 1) : r * (q + 1) + (xcd - r) * q) + off; } \
      const int nig = 4 * nN, gid = wgid / nig, fm = gid * 4, gsz = min(nM - fm, 4); \
      nbrow = (fm + ((wgid % nig) % gsz)) * 272; nbcol = ((wgid % nig) / gsz) * 256; \
      Ab = A + (size_t)nbrow * K; \
      _Pragma("unroll") for (int i = 0; i < NPASS; ++i) { const int s = i * 8 + wid; \
        if (s < 34) so[i] = (sR[i] * K + sC[i]) * 2; \
        else { int br = nbcol + sR[i]; if (br > N - 1) br = N - 1; so[i] = (br * K + sC[i]) * 2; } } } while (0)
#define GLDS_PART(buf, kt, i_lo, i_hi) do { const char* ga_ = (const char*)(Ab + (kt) * BK); const char* gb_ = (const char*)(Bt + (kt) * BK); \
    _Pragma("unroll") for (int i = (i_lo); i < (i_hi); ++i) { const int s = i * 8 + wid; \
      if (s < 66) __builtin_amdgcn_global_load_lds((const unsigned*)((s < 34 ? ga_ : gb_) + (unsigned)so[i]), (unsigned*)(lds + (buf) * STAGE_B + s * 1024), 16, 0, 0); } } while (0)
#define GLDS_STAGE(buf, kt) GLDS_PART(buf, kt, 0, NPASS)
  int w0 = blockIdx.x;
  if (w0 < nwg) { TILE_COORDS(w0); GLDS_STAGE(0, 0); }
  while (w0 < nwg) {
    const int brow = nbrow, bcol = nbcol;
    f32x4 acc[9][4];
#pragma unroll
    for (int m = 0; m < 9; ++m)
#pragma unroll
      for (int n = 0; n < 4; ++n) acc[m][n] = (f32x4){0.f, 0.f, 0.f, 0.f};
    WAIT_V0(); __syncthreads();
#pragma unroll 1
    for (int t = 0; t < nt; ++t) {
      const int cur = t & 1;
      const int tn = (t + 1 < nt) ? t + 1 : t;
      const char* sa = lds + cur * STAGE_B; const char* sb = sa + TA_B;
#pragma unroll
      for (int ks = 0; ks < KS; ++ks) {
        bf16x8 Bf[4], a0, a1;
#pragma unroll
        for (int n = 0; n < 4; ++n) Bf[n] = *(const bf16x8*)(sb + lds_byte<KS>(wc * 64 + n * 16 + fr, ks * 32 + fq * 8));
        a0 = *(const bf16x8*)(sa + lds_byte<KS>(rbase + fr, ks * 32 + fq * 8));
#pragma unroll
        for (int m = 0; m < 8; ++m) {
          if (m < 7 || wr == 0) a1 = *(const bf16x8*)(sa + lds_byte<KS>(rbase + (m + 1) * 16 + fr, ks * 32 + fq * 8));
          if (ks == 0) { if (m < 5) GLDS_PART(cur ^ 1, tn, m, m + 1); } else { if (m < 4) GLDS_PART(cur ^ 1, tn, 5 + m, 6 + m); }
          __builtin_amdgcn_s_setprio(1);
#pragma unroll
          for (int n = 0; n < 4; ++n) acc[m][n] = __builtin_amdgcn_mfma_f32_16x16x32_bf16(Bf[n], a0, acc[m][n], 0, 0, 0);
          __builtin_amdgcn_s_setprio(0);
          a0 = a1;
        }
        if (wr == 0) {
#pragma unroll
          for (int n = 0; n < 4; ++n) acc[8][n] = __builtin_amdgcn_mfma_f32_16x16x32_bf16(Bf[n], a0, acc[8][n], 0, 0, 0);
        }
      }
      WAIT_V0(); __syncthreads();
    }
    w0 += gridDim.x;
    if (w0 < nwg) { TILE_COORDS(w0); GLDS_STAGE(0, 0); }
    char* est = lds + STAGE_B + wid * 6912;
    if (EPI == 0 || EPI == 1) {
#pragma unroll
      for (int pi = 0; pi < 3; ++pi) {
#pragma unroll
        for (int mm = 0; mm < 3; ++mm) {
          const int m = pi * 3 + mm;
          if (m < 8 || wr == 0) {
#pragma unroll
            for (int n = 0; n < 4; ++n) {
              f32x4 v = acc[m][n];
              if (EPI == 1) {
#pragma unroll
                for (int j = 0; j < 4; ++j) { const float a = fmaxf(v[j], 0.f); v[j] = a * a; }
              }
              uint2 o; o.x = pack2(v[0], v[1]); o.y = pack2(v[2], v[3]);
              *(uint2*)(est + (mm * 16 + fr) * 144 + (n * 16 + fq * 4) * 2) = o;
            }
          }
        }
        asm volatile("" ::: "memory");
        const int nrows = (wr == 0 || pi < 2) ? 48 : 32;
#pragma unroll
        for (int q = 0; q < 6; ++q) {
          const int idx = q * 64 + lane, rl = idx >> 3, ch = idx & 7;
          const uint4 val = *(const uint4*)(est + rl * 144 + ch * 16);
          const int row = brow + rbase + pi * 48 + rl, col = bcol + wc * 64 + ch * 8;
          if (rl < nrows && col < N) *(uint4*)(outb + (size_t)row * ldo + col) = val;
        }
        asm volatile("" ::: "memory");
      }
    } else {
      const int ch = lane & 15, rq4 = lane >> 4;
      const int col = bcol + wc * 64 + ch * 4;
      const int bidx0 = brow / NTB;
      const float4 md_lat = *(const float4*)(modv + (size_t)bidx0 * 6144 + col);
      float4 xc[4], xn[4];
#pragma unroll
      for (int q = 0; q < 4; ++q) xc[q] = *(const float4*)(xrow_src(p, brow + rbase + q * 4 + rq4, first) + col);
#pragma unroll
      for (int m = 0; m < 9; ++m) {
        if (m < 8 || wr == 0) {
#pragma unroll
          for (int n = 0; n < 4; ++n) *(f32x4*)(est + fr * 272 + (n * 16 + fq * 4) * 4) = acc[m][n];
          if (m < 7 || (m == 7 && wr == 0)) {
#pragma unroll
            for (int q = 0; q < 4; ++q) xn[q] = *(const float4*)(xrow_src(p, brow + rbase + (m + 1) * 16 + q * 4 + rq4, first) + col);
          }
          asm volatile("" ::: "memory");
#pragma unroll
          for (int q = 0; q < 4; ++q) {
            const int rl = q * 4 + rq4;
            const float4 v = *(const float4*)(est + rl * 272 + ch * 16);
            const int row = brow + rbase + m * 16 + rl;
            const bool isctx = (row - bidx0 * NTB) < 256;
            float4 md = md_lat;
            if (isctx) md = *(const float4*)(modv + (size_t)8 * 6144 + col);
            float4 cur = xc[q];
            cur.x += md.x * v.x; cur.y += md.y * v.y; cur.z += md.z * v.z; cur.w += md.w * v.w;
            *(float4*)(xrow(p, row) + col) = cur;
          }
#pragma unroll
          for (int q = 0; q < 4; ++q) xc[q] = xn[q];
          asm volatile("" ::: "memory");
        }
      }
    }
  }
}

#undef GLDS_STAGE
#undef GLDS_PART
#undef TILE_COORDS

__device__ void chain_idle() {
  for (int pos = 0; pos < NTB; ++pos) { __syncthreads(); __syncthreads(); }
}

__device__ void chain_ret(const Params& p, int layer, int item, float* wl) {
  const int lane = otid() & 63;
  const int b = item >> 4, h = (item >> 2) & 3, dir = (item >> 1) & 1, vs = item & 1;
  const int e = layer >> 1;
  const bf16_t* proj = (const bf16_t*)(p.ws + OFF_BIG);
  bf16_t* ob = (bf16_t*)(p.ws + (dir ? OFF_BUFA : OFF_BUFB));
  const float* ct = (const float*)(p.ws + OFF_ROPE); const float* st = ct + 4096 * 32;
  const float gam = expf(p.in[19][(e * 2 + dir) * 4 + h]);
  float s[64];
#pragma unroll
  for (int d = 0; d < 64; ++d) s[d] = 0.f;
  float2* qk = (float2*)wl;
  for (int pos = 0; pos < NTB; ++pos) {
    const int n = scan2nat(pos, dir);
    const size_t g = (size_t)b * NTB + n;
    const bf16_t* row = proj + g * EV_IN;
    float qv = bf2f(row[1024 + h * 64 + lane]);
    float kv = bf2f(row[1280 + h * 64 + lane]) * 0.125f;
    float vv = bf2f(row[1536 + h * 128 + vs * 64 + lane]);
    float qo = __shfl_xor(qv, 32), ko = __shfl_xor(kv, 32);
    if (n >= 256) {
      int t = n - 256, pp = lane & 31;
      float c = ct[t * 32 + pp], sn = st[t * 32 + pp];
      if (lane < 32) { qv = qv * c - qo * sn; kv = kv * c - ko * sn; }
      else { qv = qo * sn + qv * c; kv = ko * sn + kv * c; }
    }
    qk[lane] = make_float2(qv, kv);
    __syncthreads();
    float o = 0.f;
#pragma unroll
    for (int d = 0; d < 64; d += 2) {
      float4 t4 = *(const float4*)(qk + d);
      s[d] = gam * s[d] + t4.y * vv; o += t4.x * s[d];
      s[d + 1] = gam * s[d + 1] + t4.w * vv; o += t4.z * s[d + 1];
      if ((d & 7) == 6) asm volatile("" ::: "memory");
    }
    ob[g * DM + 512 + h * 128 + vs * 64 + lane] = f2bf(o);
    __syncthreads();
  }
}

__device__ void chain_lru(const Params& p, int layer, int item, float* wl) {
  const int lane = otid() & 63;
  const int part = item & 1, kb = (item >> 1) & 7, dir = (item >> 4) & 1, b = item >> 5;
  const int e = layer >> 1;
  const int dh = lane >> 5, jl = (lane & 31) + 32 * part;
  const int chu = kb * 64 + lane;
  const int cho = kb * 64 + jl;
  const bf16_t* proj = (const bf16_t*)(p.ws + OFF_BIG);
  bf16_t* ob = (bf16_t*)(p.ws + (dir ? OFF_BUFA : OFF_BUFB));
  float cw[4];
#pragma unroll
  for (int t = 0; t < 4; ++t) cw[t] = p.in[12][(e * 4 + t) * 512 + chu];
  const float cb = p.in[13][e * 512 + chu];
  float wa[32], wx[32];
  {
    const float* wap = p.in[14] + ((size_t)((e * 2 + dir) * 8 + kb) * 64 + 32 * dh) * 64 + jl;
    const float* wxp = p.in[16] + ((size_t)((e * 2 + dir) * 8 + kb) * 64 + 32 * dh) * 64 + jl;
#pragma unroll
    for (int i = 0; i < 32; ++i) { wa[i] = wap[i * 64]; wx[i] = wxp[i * 64]; }
  }
  const float ba = p.in[15][(e * 2 + dir) * 512 + cho], bx = p.in[17][(e * 2 + dir) * 512 + cho];
  const float lam = p.in[18][(e * 2 + dir) * 512 + cho];
  const float spc = -8.f * softplusf_(-lam);
  float hst = 0.f;
  const float* wlh = wl + 32 * dh;
  for (int pos = 0; pos < NTB; ++pos) {
    const int n = scan2nat(pos, dir);
    const size_t g = (size_t)b * NTB + n;
    const int lo = n < 256 ? 0 : 256, hi = n < 256 ? 256 : NTB;
    float u = cb;
#pragma unroll
    for (int t = 0; t < 4; ++t) {
      int nn = n + t - 2;
      if (nn >= lo && nn < hi) u += cw[t] * bf2f(proj[((size_t)b * NTB + nn) * EV_IN + chu]);
    }
    wl[lane] = u;
    __syncthreads();
    float rp = 0.f, ip = 0.f;
#pragma unroll
    for (int i = 0; i < 32; i += 4) {
      float4 u4 = *(const float4*)(wlh + i);
      rp += u4.x * wa[i] + u4.y * wa[i + 1] + u4.z * wa[i + 2] + u4.w * wa[i + 3];
      ip += u4.x * wx[i] + u4.y * wx[i + 1] + u4.z * wx[i + 2] + u4.w * wx[i + 3];
    }
    rp += __shfl_xor(rp, 32); ip += __shfl_xor(ip, 32);
    rp += ba; ip += bx;
    float uo = wl[jl];
    float r = sigmoidf_(rp), ig = sigmoidf_(ip);
    float la = spc * r;
    float a = expf(la);
    float bb = sqrtf(-expm1f(2.f * la)) * ig * uo;
    hst = a * hst + bb;
    if (dh == 0) ob[g * DM + cho] = f2bf(hst);
    __syncthreads();
  }
}

__device__ void chain_gla(const Params& p, int layer, int item, float* wl) {
  const int lane = otid() & 63;
  const int vs4 = item & 3, dir = (item >> 2) & 1, h = (item >> 3) & 3, b = item >> 5;
  const int o_ = layer >> 1;
  const int dh = lane >> 5, vl = lane & 31;
  const bf16_t* proj = (const bf16_t*)(p.ws + OFF_BIG);
  bf16_t* ob = (bf16_t*)(p.ws + (dir ? OFF_BUFA : OFF_BUFB));
  float lb[2];
#pragma unroll
  for (int j = 0; j < 2; ++j) {
    int d = h * 128 + lane + 64 * j;
    float l0 = p.in[21][(dir * 2 + 0) * 512 + d], l1 = p.in[21][(dir * 2 + 1) * 512 + d];
    lb[j] = o_ == 0 ? 0.f : 1.f / (1.f + expf(l0 - l1));
  }
  float s[64];
#pragma unroll
  for (int d = 0; d < 64; ++d) s[d] = 0.f;
  float4* st4 = (float4*)wl;
  const float4* st4h = st4 + 64 * dh;
  for (int pos = 0; pos < NTB; ++pos) {
    const int n = scan2nat(pos, dir);
    const size_t g = (size_t)b * NTB + n;
    const bf16_t* row = proj + g * OD_IN;
#pragma unroll
    for (int j = 0; j < 2; ++j) {
      int d = lane + 64 * j;
      float hq = bf2f(row[h * 128 + d]);
      float fp = bf2f(row[(dir ? 1024 : 512) + h * 128 + d]);
      float sg = sigmoidf_(fp);
      float f = lb[j] + (1.f - lb[j]) * sg;
      st4[d] = make_float4(f, 1.f - f, siluf_(hq), 0.f);
    }
    float vv = bf2f(row[1536 + h * 128 + vs4 * 32 + vl]);
    __syncthreads();
    float o = 0.f;
#pragma unroll
    for (int d = 0; d < 64; ++d) {
      float4 t4 = st4h[d];
      s[d] = t4.x * s[d] + t4.y * vv; o += t4.z * s[d];
      if ((d & 3) == 3) asm volatile("" ::: "memory");
    }
    o += __shfl_xor(o, 32);
    if (dh == 0) ob[g * DM + h * 128 + vs4 * 32 + vl] = f2bf(o);
    __syncthreads();
  }
}

__device__ void chain_gdn(const Params& p, int layer, int item, float* wl) {
  const int lane = otid() & 63;
  const int vs4 = item & 3, dir = (item >> 2) & 1, h = (item >> 3) & 3, b = item >> 5;
  const int o_ = layer >> 1;
  const int dh = lane >> 5, vl = lane & 31;
  const bf16_t* proj = (const bf16_t*)(p.ws + OFF_BIG);
  bf16_t* ob = (bf16_t*)(p.ws + (dir ? OFF_BUFA : OFF_BUFB));
  int cch[5], pcol[5];
  cch[0] = h * 128 + lane;        pcol[0] = 2560 + cch[0];
  cch[1] = h * 128 + lane + 64;   pcol[1] = 2560 + cch[1];
  cch[2] = 512 + h * 128 + lane;  pcol[2] = 2560 + cch[2];
  cch[3] = 512 + h * 128 + lane + 64; pcol[3] = 2560 + cch[3];
  cch[4] = 1024 + h * 128 + vs4 * 32 + vl; pcol[4] = 2560 + cch[4];
  float cw[5][4];
#pragma unroll
  for (int j = 0; j < 5; ++j)
#pragma unroll
    for (int t = 0; t < 4; ++t) cw[j][t] = p.in[22][((size_t)o_ * 4 + t) * 1536 + cch[j]];
  const float aexp = expf(p.in[23][(o_ * 2 + dir) * 4 + h]);
  const float dtb = p.in[24][(o_ * 2 + dir) * 4 + h];
  float s[64];
#pragma unroll
  for (int d = 0; d < 64; ++d) s[d] = 0.f;
  float2* qk = (float2*)wl;
  const float2* qkh = qk + 64 * dh;
  for (int pos = 0; pos < NTB; ++pos) {
    const int n = scan2nat(pos, dir);
    const size_t g = (size_t)b * NTB + n;
    const int lo = n < 256 ? 0 : 256, hi = n < 256 ? 256 : NTB;
    float cv[5];
#pragma unroll
    for (int j = 0; j < 5; ++j) cv[j] = 0.f;
#pragma unroll
    for (int t = 0; t < 4; ++t) {
      int nn = n + t - 2;
      if (nn >= lo && nn < hi) {
        const bf16_t* rr = proj + ((size_t)b * NTB + nn) * OD_IN;
#pragma unroll
        for (int j = 0; j < 5; ++j) cv[j] += cw[j][t] * bf2f(rr[pcol[j]]);
      }
    }
#pragma unroll
    for (int j = 0; j < 5; ++j) cv[j] = siluf_(cv[j]);
    float sq = wave_sum(cv[0] * cv[0] + cv[1] * cv[1]);
    float sk = wave_sum(cv[2] * cv[2] + cv[3] * cv[3]);
    float rq = rsqrtf(sq + 1e-6f) * 0.08838834764831845f, rk = rsqrtf(sk + 1e-6f);
    qk[lane] = make_float2(cv[0] * rq, cv[2] * rk);
    qk[lane + 64] = make_float2(cv[1] * rq, cv[3] * rk);
    const bf16_t* row = proj + g * OD_IN;
    float beta = sigmoidf_(bf2f(row[4608 + dir * 4 + h]));
    float gg = -aexp * softplusf_(bf2f(row[4616 + dir * 4 + h]) + dtb);
    float alpha = expf(gg);
    __syncthreads();
    float kS = 0.f;
#pragma unroll
    for (int d = 0; d < 64; d += 2) {
      float4 t4 = *(const float4*)(qkh + d);
      kS += t4.y * s[d] + t4.w * s[d + 1];
      if ((d & 7) == 6) asm volatile("" ::: "memory");
    }
    kS += __shfl_xor(kS, 32);
    float vn = beta * (cv[4] - alpha * kS);
    float o = 0.f;
#pragma unroll
    for (int d = 0; d < 64; d += 2) {
      float4 t4 = *(const float4*)(qkh + d);
      s[d] = alpha * s[d] + t4.y * vn; o += t4.x * s[d];
      s[d + 1] = alpha * s[d + 1] + t4.w * vn; o += t4.z * s[d + 1];
      if ((d & 7) == 6) asm volatile("" ::: "memory");
    }
    o += __shfl_xor(o, 32);
    if (dh == 0) ob[g * DM + 512 + h * 128 + vs4 * 32 + vl] = f2bf(o);
    __syncthreads();
  }
}

template <int TM, int TN, int K>
__device__ __forceinline__ void lds_mma(const bf16_t* A, int lda, const bf16_t* B, int ldb, int m0, int n0, f32x4 (&acc)[TM][TN], int lane) {
  const int l15 = lane & 15, quad = lane >> 4;
  const bf16_t* ap = A + (m0 + l15) * lda + quad * 8;
  const bf16_t* bp = B + (n0 + l15) * ldb + quad * 8;
#pragma unroll
  for (int k = 0; k < K; k += 32) {
    bf16x8 a[TM], b[TN];
#pragma unroll
    for (int i = 0; i < TM; ++i) a[i] = *(const bf16x8*)(ap + i * 16 * lda + k);
#pragma unroll
    for (int j = 0; j < TN; ++j) b[j] = *(const bf16x8*)(bp + j * 16 * ldb + k);
#pragma unroll
    for (int i = 0; i < TM; ++i)
#pragma unroll
      for (int j = 0; j < TN; ++j) acc[i][j] = __builtin_amdgcn_mfma_f32_16x16x32_bf16(a[i], b[j], acc[i][j], 0, 0, 0);
  }
}
__device__ __forceinline__ void unpack8(uint4 u, float* f) {
  f[0] = __uint_as_float(u.x << 16); f[1] = __uint_as_float(u.x & 0xffff0000u);
  f[2] = __uint_as_float(u.y << 16); f[3] = __uint_as_float(u.y & 0xffff0000u);
  f[4] = __uint_as_float(u.z << 16); f[5] = __uint_as_float(u.z & 0xffff0000u);
  f[6] = __uint_as_float(u.w << 16); f[7] = __uint_as_float(u.w & 0xffff0000u);
}
__device__ __forceinline__ uint4 pack8(const float* f) {
  uint4 u; u.x = pack2(f[0], f[1]); u.y = pack2(f[2], f[3]); u.z = pack2(f[4], f[5]); u.w = pack2(f[6], f[7]); return u;
}

__device__ __forceinline__ void cret(const Params& p, int layer, int item, char* lds) {
  const int tid = otid(), lane = tid & 63, wave = tid >> 6, l15 = lane & 15, quad = lane >> 4;
  const int b = item >> 4, h = (item >> 2) & 3, dir = (item >> 1) & 1, vs = item & 1;
  const int e = layer >> 1;
  const bf16_t* proj = (const bf16_t*)(p.ws + OFF_BIG);
  bf16_t* ob = (bf16_t*)(p.ws + (dir ? OFF_BUFA : OFF_BUFB));
  const float* ct = (const float*)(p.ws + OFF_ROPE); const float* st = ct + 4096 * 32;
  const float lg = p.in[19][(e * 2 + dir) * 4 + h];
  bf16_t* PQ = (bf16_t*)lds;
  bf16_t* Ks = PQ + 128 * 200;
  bf16_t* KT = Ks + 128 * 72;
  bf16_t* VB = KT + 64 * 136;
  bf16_t* V2T = VB + 64 * 200;
  const float cdec = __expf(lg * 128.f);
  f32x4 S[1][2];
  S[0][0] = (f32x4){0.f, 0.f, 0.f, 0.f}; S[0][1] = S[0][0];
  for (int i = tid; i < 64 * 64; i += NTHREADS) VB[(i >> 6) * 200 + 128 + (i & 63)] = 0;
  const int si = tid >> 2, sq = tid & 3;
  const float qd = __expf(lg * (float)(si + 1)), kd = __expf(lg * (float)(127 - si));
  uint4 rr_[6]; float4 rc_[4];
  int rn_ = 0;
#define RET_LOAD(cc) do { rn_ = scan2nat((cc) * 128 + si, dir); const bf16_t* row_ = proj + ((size_t)b * NTB + rn_) * EV_IN; \
    rr_[0] = *(const uint4*)(row_ + 1024 + h * 64 + 8 * sq); rr_[1] = *(const uint4*)(row_ + 1024 + h * 64 + 32 + 8 * sq); \
    rr_[2] = *(const uint4*)(row_ + 1280 + h * 64 + 8 * sq); rr_[3] = *(const uint4*)(row_ + 1280 + h * 64 + 32 + 8 * sq); \
    rr_[4] = *(const uint4*)(row_ + 1536 + h * 128 + vs * 64 + 16 * sq); rr_[5] = *(const uint4*)(row_ + 1536 + h * 128 + vs * 64 + 16 * sq + 8); \
    { const int tt_ = rn_ >= 256 ? rn_ - 256 : 0; const float* cp_ = ct + tt_ * 32 + 8 * sq; const float* sp_ = st + tt_ * 32 + 8 * sq; \
      rc_[0] = *(const float4*)cp_; rc_[1] = *(const float4*)(cp_ + 4); rc_[2] = *(const float4*)sp_; rc_[3] = *(const float4*)(sp_ + 4); } } while (0)
  RET_LOAD(0);
  for (int c = 0; c < 34; ++c) {
    {
      const int n = rn_;
      float q1[8], q2[8], k1[8], k2[8];
      unpack8(rr_[0], q1);
      unpack8(rr_[1], q2);
      unpack8(rr_[2], k1);
      unpack8(rr_[3], k2);
      float vv[16];
      unpack8(rr_[4], vv);
      unpack8(rr_[5], vv + 8);
      float cc[8], ss[8];
      *(float4*)cc = rc_[0]; *(float4*)(cc + 4) = rc_[1];
      *(float4*)ss = rc_[2]; *(float4*)(ss + 4) = rc_[3];
      if (c + 1 < 34) RET_LOAD(c + 1);
      if (n >= 256) {
#pragma unroll
        for (int j = 0; j < 8; ++j) {
          float a1 = q1[j] * cc[j] - q2[j] * ss[j], a2 = q1[j] * ss[j] + q2[j] * cc[j]; q1[j] = a1; q2[j] = a2;
          float b1 = k1[j] * cc[j] - k2[j] * ss[j], b2 = k1[j] * ss[j] + k2[j] * cc[j]; k1[j] = b1; k2[j] = b2;
        }
      }
#pragma unroll
      for (int j = 0; j < 8; ++j) { q1[j] *= qd; q2[j] *= qd; k1[j] *= 0.125f; k2[j] *= 0.125f; }
      *(uint4*)(PQ + si * 200 + 128 + 8 * sq) = pack8(q1);
      *(uint4*)(PQ + si * 200 + 160 + 8 * sq) = pack8(q2);
      *(uint4*)(Ks + si * 72 + 8 * sq) = pack8(k1);
      *(uint4*)(Ks + si * 72 + 32 + 8 * sq) = pack8(k2);
#pragma unroll
      for (int j = 0; j < 8; ++j) { KT[(8 * sq + j) * 136 + si] = f2bf(k1[j]); KT[(32 + 8 * sq + j) * 136 + si] = f2bf(k2[j]); }
#pragma unroll
      for (int j = 0; j < 16; ++j) { VB[(16 * sq + j) * 200 + si] = f2bf(vv[j]); V2T[(16 * sq + j) * 136 + si] = f2bf(vv[j] * kd); }
    }
    __syncthreads();
    {
      const int m0 = wave * 16;
#pragma unroll
      for (int nt = 0; nt < 8; ++nt) {
        f32x4 acc[1][1]; acc[0][0] = (f32x4){0.f, 0.f, 0.f, 0.f};
        if (nt <= wave) lds_mma<1, 1, 64>(PQ + 128, 200, Ks, 72, m0, nt * 16, acc, lane);
        const int j = nt * 16 + l15;
        const float sc = __expf(-lg * (float)(j + 1));
#pragma unroll
        for (int r = 0; r < 4; ++r) {
          const int i = m0 + quad * 4 + r;
          float v = (nt <= wave && i >= j) ? acc[0][0][r] * sc : 0.f;
          PQ[i * 200 + j] = f2bf(v);
        }
      }
    }
    __syncthreads();
    {
      const int m0 = wave * 16;
      f32x4 acc[1][4];
#pragma unroll
      for (int j = 0; j < 4; ++j) acc[0][j] = (f32x4){0.f, 0.f, 0.f, 0.f};
      lds_mma<1, 4, 192>(PQ, 200, VB, 200, m0, 0, acc, lane);
#pragma unroll
      for (int r = 0; r < 4; ++r) {
        const int i = m0 + quad * 4 + r;
        const int n = scan2nat(c * 128 + i, dir);
        bf16_t* orow = ob + ((size_t)b * NTB + n) * DM + 512 + h * 128 + vs * 64 + l15;
#pragma unroll
        for (int j = 0; j < 4; ++j) orow[j * 16] = f2bf(acc[0][j][r]);
      }
    }
    const int sm0 = (wave >> 1) * 16, sn0 = (wave & 1) * 32;
    {
      S[0][0] *= cdec; S[0][1] *= cdec;
      lds_mma<1, 2, 128>(KT, 136, V2T, 136, sm0, sn0, S, lane);
    }
    __syncthreads();
#pragma unroll
    for (int j = 0; j < 2; ++j) {
      const int v = sn0 + j * 16 + l15, d = sm0 + quad * 4;
      uint2 u; u.x = pack2(S[0][j][0], S[0][j][1]); u.y = pack2(S[0][j][2], S[0][j][3]);
      *(uint2*)(VB + v * 200 + 128 + d) = u;
    }
  }
  __syncthreads();
}

__device__ __forceinline__ void clru(const Params& p, int layer, int item, char* lds) {
  const int tid = otid(), lane = tid & 63, wave = tid >> 6, l15 = lane & 15, quad = lane >> 4;
  const int kb = item & 7, dir = (item >> 3) & 1, b = item >> 4;
  const int e = layer >> 1;
  const bf16_t* proj = (const bf16_t*)(p.ws + OFF_BIG);
  bf16_t* ob = (bf16_t*)(p.ws + (dir ? OFF_BUFA : OFF_BUFB));
  bf16_t* Wt = (bf16_t*)lds;
  bf16_t* Ub = Wt + 128 * 72;
  float* Uf = (float*)(Ub + 64 * 72);
  float* LA = Uf + 64 * 64;
  float* IG = LA + 64 * 64;
  float* Hs = IG + 64 * 64;
  {
    const float* wap = p.in[14] + ((size_t)((e * 2 + dir) * 8 + kb) * 64) * 64;
    const float* wxp = p.in[16] + ((size_t)((e * 2 + dir) * 8 + kb) * 64) * 64;
    for (int i = tid; i < 4096; i += NTHREADS) {
      int ii = i >> 6, jj = i & 63;
      Wt[jj * 72 + ii] = f2bf(wap[i]);
      Wt[(64 + jj) * 72 + ii] = f2bf(wxp[i]);
    }
  }
  const int si = tid >> 3, sp = tid & 7;
  float cw[4][8], cb[8];
#pragma unroll
  for (int j = 0; j < 8; ++j) {
    const int ch = kb * 64 + sp * 8 + j;
    cb[j] = p.in[13][e * 512 + ch];
#pragma unroll
    for (int t = 0; t < 4; ++t) cw[t][j] = p.in[12][(e * 4 + t) * 512 + ch];
  }
  float gba[2], gbx[2], gsl[2];
#pragma unroll
  for (int t = 0; t < 2; ++t) {
    const int ch = kb * 64 + (wave & 1) * 32 + t * 16 + l15;
    gba[t] = p.in[15][(e * 2 + dir) * 512 + ch];
    gbx[t] = p.in[17][(e * 2 + dir) * 512 + ch];
    gsl[t] = -8.f * softplusf_(-p.in[18][(e * 2 + dir) * 512 + ch]);
  }
  float hst = 0.f;
  __syncthreads();
  uint4 rx[4];
#define LRU_LOAD(cc) do { const int n_ = scan2nat((cc) * 64 + si, dir); const int lo_ = n_ < 256 ? 0 : 256, hi_ = n_ < 256 ? 256 : NTB; \
    _Pragma("unroll") for (int t = 0; t < 4; ++t) { const int nn = n_ + t - 2; const bool ok = (nn >= lo_ && nn < hi_); \
      const uint4 v_ = *(const uint4*)(proj + ((size_t)b * NTB + (ok ? nn : n_)) * EV_IN + kb * 64 + sp * 8); \
      rx[t] = ok ? v_ : make_uint4(0u, 0u, 0u, 0u); } } while (0)
  LRU_LOAD(0);
  for (int c = 0; c < 68; ++c) {
    {
      float u[8];
#pragma unroll
      for (int j = 0; j < 8; ++j) u[j] = cb[j];
#pragma unroll
      for (int t = 0; t < 4; ++t) {
        float xv[8];
        unpack8(rx[t], xv);
#pragma unroll
        for (int j = 0; j < 8; ++j) u[j] += cw[t][j] * xv[j];
      }
      if (c + 1 < 68) LRU_LOAD(c + 1);
      *(float4*)(Uf + si * 64 + sp * 8) = *(float4*)u;
      *(float4*)(Uf + si * 64 + sp * 8 + 4) = *(float4*)(u + 4);
      *(uint4*)(Ub + si * 72 + sp * 8) = pack8(u);
    }
    __syncthreads();
    {
      const int m0 = (wave >> 1) * 16, n0 = (wave & 1) * 32;
      f32x4 ar[1][2], ai[1][2];
      ar[0][0] = (f32x4){0.f, 0.f, 0.f, 0.f}; ar[0][1] = ar[0][0]; ai[0][0] = ar[0][0]; ai[0][1] = ar[0][0];
      lds_mma<1, 2, 64>(Ub, 72, Wt, 72, m0, n0, ar, lane);
      lds_mma<1, 2, 64>(Ub, 72, Wt, 72, m0, 64 + n0, ai, lane);
#pragma unroll
      for (int t = 0; t < 2; ++t) {
        const int jj = n0 + t * 16 + l15;
#pragma unroll
        for (int r = 0; r < 4; ++r) {
          const int i = m0 + quad * 4 + r;
          const float la = gsl[t] * sigmoidf_(ar[0][t][r] + gba[t]);
          const float ig = sigmoidf_(ai[0][t][r] + gbx[t]);
          const float a = __expf(la);
          LA[i * 64 + jj] = a;
          IG[i * 64 + jj] = __builtin_amdgcn_sqrtf(fmaxf(1.f - a * a, 0.f)) * ig * Uf[i * 64 + jj];
        }
      }
    }
    __syncthreads();
    if (wave == 0) {
#pragma unroll
      for (int bq = 0; bq < 4; ++bq) {
        float av[16], bv[16];
#pragma unroll
        for (int i = 0; i < 16; ++i) { av[i] = LA[(bq * 16 + i) * 64 + lane]; bv[i] = IG[(bq * 16 + i) * 64 + lane]; }
#pragma unroll
        for (int i = 0; i < 16; ++i) { hst = av[i] * hst + bv[i]; Hs[(bq * 16 + i) * 64 + lane] = hst; }
      }
    }
    __syncthreads();
    {
      const int n = scan2nat(c * 64 + si, dir);
      float hv[8];
      *(float4*)hv = *(const float4*)(Hs + si * 64 + sp * 8);
      *(float4*)(hv + 4) = *(const float4*)(Hs + si * 64 + sp * 8 + 4);
      *(uint4*)(ob + ((size_t)b * NTB + n) * DM + kb * 64 + sp * 8) = pack8(hv);
    }
  }
  __syncthreads();
}

__device__ __forceinline__ void cgla(const Params& p, int layer, int item, char* lds) {
  const int tid = otid(), lane = tid & 63, wave = tid >> 6, l15 = lane & 15, quad = lane >> 4;
  const int b = item >> 4, h = (item >> 2) & 3, dir = (item >> 1) & 1, vs = item & 1;
  const int o_ = layer >> 1;
  const bf16_t* proj = (const bf16_t*)(p.ws + OFF_BIG);
  bf16_t* ob = (bf16_t*)(p.ws + (dir ? OFF_BUFA : OFF_BUFB));
  float* AF = (float*)lds;
  bf16_t* PQ = (bf16_t*)(lds + 32768);
  bf16_t* Qt = PQ + 64 * 200;
  bf16_t* Kt = Qt + 64 * 136;
  bf16_t* VB = Kt + 64 * 136;
  bf16_t* K3T = VB + 64 * 200;
  float* LB = (float*)(K3T + 128 * 72);
  if (tid < 128) {
    const int d = h * 128 + tid;
    float l0 = p.in[21][(dir * 2 + 0) * 512 + d], l1 = p.in[21][(dir * 2 + 1) * 512 + d];
    LB[tid] = o_ == 0 ? 0.f : 1.f / (1.f + __expf(l0 - l1));
  }
  for (int i = tid; i < 64 * 128; i += NTHREADS) VB[(i >> 7) * 200 + 64 + (i & 127)] = 0;
  f32x4 S[1][4];
#pragma unroll
  for (int j = 0; j < 4; ++j) S[0][j] = (f32x4){0.f, 0.f, 0.f, 0.f};
  const int si = tid >> 3, sp = tid & 7;
  __syncthreads();
  for (int c = 0; c < 68; ++c) {
    float qr[16], kr[16];
    const int n_s = scan2nat(c * 64 + si, dir);
    const bf16_t* row = proj + ((size_t)b * NTB + n_s) * OD_IN;
    {
      float fp[16];
      unpack8(*(const uint4*)(row + h * 128 + 16 * sp), qr);
      unpack8(*(const uint4*)(row + h * 128 + 16 * sp + 8), qr + 8);
      unpack8(*(const uint4*)(row + (dir ? 1024 : 512) + h * 128 + 16 * sp), fp);
      unpack8(*(const uint4*)(row + (dir ? 1024 : 512) + h * 128 + 16 * sp + 8), fp + 8);
#pragma unroll
      for (int j = 0; j < 16; ++j) {
        const float lb = LB[16 * sp + j];
        const float f = lb + (1.f - lb) * sigmoidf_(fp[j]);
        kr[j] = 1.f - f;
        qr[j] = siluf_(qr[j]);
        AF[si * 128 + 16 * sp + j] = __logf(f);
      }
      float vv[8];
      unpack8(*(const uint4*)(row + 1536 + h * 128 + vs * 64 + 8 * sp), vv);
#pragma unroll
      for (int j = 0; j < 8; ++j) VB[(8 * sp + j) * 200 + si] = f2bf(vv[j]);
    }
    __syncthreads();
    if (tid < 128) {
      float a = 0.f;
#pragma unroll 8
      for (int i = 0; i < 64; ++i) { a += AF[i * 128 + tid]; AF[i * 128 + tid] = a; }
    }
    __syncthreads();
    {
      float t1[16], t2[16], t3[16];
#pragma unroll
      for (int j = 0; j < 16; ++j) {
        const int d = 16 * sp + j;
        const float a = AF[si * 128 + d], rr = AF[31 * 128 + d], al = AF[63 * 128 + d];
        t1[j] = qr[j] * __expf(a - rr);
        t2[j] = kr[j] * __expf(rr - a);
        t3[j] = qr[j] * __expf(a);
        K3T[d * 72 + si] = f2bf(kr[j] * __expf(al - a));
      }
      *(uint4*)(Qt + si * 136 + 16 * sp) = pack8(t1); *(uint4*)(Qt + si * 136 + 16 * sp + 8) = pack8(t1 + 8);
      *(uint4*)(Kt + si * 136 + 16 * sp) = pack8(t2); *(uint4*)(Kt + si * 136 + 16 * sp + 8) = pack8(t2 + 8);
      *(uint4*)(PQ + si * 200 + 64 + 16 * sp) = pack8(t3); *(uint4*)(PQ + si * 200 + 64 + 16 * sp + 8) = pack8(t3 + 8);
    }
    __syncthreads();
    {
      const int m0 = (wave >> 1) * 16, n0 = (wave & 1) * 32;
      f32x4 acc[1][2]; acc[0][0] = (f32x4){0.f, 0.f, 0.f, 0.f}; acc[0][1] = acc[0][0];
      lds_mma<1, 2, 128>(Qt, 136, Kt, 136, m0, n0, acc, lane);
#pragma unroll
      for (int j = 0; j < 2; ++j)
#pragma unroll
        for (int r = 0; r < 4; ++r) {
          const int i = m0 + quad * 4 + r, jj = n0 + j * 16 + l15;
          PQ[i * 200 + jj] = f2bf(i >= jj ? acc[0][j][r] : 0.f);
        }
    }
    __syncthreads();
    {
      const int m0 = (wave >> 1) * 16, n0 = (wave & 1) * 32;
      f32x4 acc[1][2]; acc[0][0] = (f32x4){0.f, 0.f, 0.f, 0.f}; acc[0][1] = acc[0][0];
      lds_mma<1, 2, 192>(PQ, 200, VB, 200, m0, n0, acc, lane);
#pragma unroll
      for (int r = 0; r < 4; ++r) {
        const int i = m0 + quad * 4 + r;
        const int n = scan2nat(c * 64 + i, dir);
        bf16_t* orow = ob + ((size_t)b * NTB + n) * DM + h * 128 + vs * 64 + n0 + l15;
        orow[0] = f2bf(acc[0][0][r]); orow[16] = f2bf(acc[0][1][r]);
      }
    }
    {
      const int m0 = wave * 16;
#pragma unroll
      for (int r = 0; r < 4; ++r) {
        const float dec = __expf(AF[63 * 128 + m0 + quad * 4 + r]);
#pragma unroll
        for (int j = 0; j < 4; ++j) S[0][j][r] *= dec;
      }
      lds_mma<1, 4, 64>(K3T, 72, VB, 200, m0, 0, S, lane);
    }
    __syncthreads();
#pragma unroll
    for (int j = 0; j < 4; ++j) {
      const int v = j * 16 + l15, d = wave * 16 + quad * 4;
      uint2 u; u.x = pack2(S[0][j][0], S[0][j][1]); u.y = pack2(S[0][j][2], S[0][j][3]);
      *(uint2*)(VB + v * 200 + 64 + d) = u;
    }
  }
  __syncthreads();
}

#define OFF_GC   506527744ull
#define OFF_BETA 507641856ull
__device__ __forceinline__ void gdn_prep_phase(const Params& p, int layer, char* lds) {
  const int tid = otid(), lane = tid & 63, wave = tid >> 6, l15 = lane & 15, quad = lane >> 4;
  const int o_ = layer >> 1;
  const bf16_t* proj = (const bf16_t*)(p.ws + OFF_BIG);
  bf16_t* Ks = (bf16_t*)lds;
  float* KK = (float*)(Ks + 64 * 136);
  float* Mf = KK + 64 * 68;
  float* CWA = Mf + 2 * 64 * 68;
  float* sm = CWA + 2048;
  float* gcg = (float*)(p.ws + OFF_GC);
  float* btg = (float*)(p.ws + OFF_BETA);
  const int si = tid >> 3, sp = tid & 7;
  for (int i = tid; i < 2048; i += NTHREADS) {
    const int hh = i >> 9, t = (i >> 7) & 3, d = i & 127;
    CWA[i] = p.in[22][((size_t)o_ * 4 + t) * 1536 + 512 + hh * 128 + d];
  }
  uint4 pk[4][2]; float pgb = 0.f, pga = 0.f;
#define PREP_LOAD(it_) do { const int cn_ = (it_) % 68, h_ = ((it_) / 68) & 3, b_ = (it_) / 272; \
    const int n_ = cn_ * 64 + si; const int lo_ = n_ < 256 ? 0 : 256, hi_ = n_ < 256 ? 256 : NTB; \
    _Pragma("unroll") for (int t = 0; t < 4; ++t) { const int nn = n_ + t - 2; const bool ok = (nn >= lo_ && nn < hi_); \
      const bf16_t* rr = proj + ((size_t)b_ * NTB + (ok ? nn : n_)) * OD_IN + 3072 + h_ * 128 + 16 * sp; \
      const uint4 a_ = *(const uint4*)rr, c_ = *(const uint4*)(rr + 8); \
      pk[t][0] = ok ? a_ : make_uint4(0u, 0u, 0u, 0u); pk[t][1] = ok ? c_ : make_uint4(0u, 0u, 0u, 0u); } \
    if (wave < 2) { const int ng_ = wave ? (cn_ * 64 + 63 - lane) : (cn_ * 64 + lane); \
      const bf16_t* row_ = proj + ((size_t)b_ * NTB + ng_) * OD_IN; \
      pgb = bf2f(row_[4608 + wave * 4 + h_]); pga = bf2f(row_[4616 + wave * 4 + h_]); } } while (0)
  if ((int)blockIdx.x < 8 * 4 * 68) PREP_LOAD((int)blockIdx.x);
  __syncthreads();
  for (int item = blockIdx.x; item < 8 * 4 * 68; item += gridDim.x) {
    const int cn = item % 68, h = (item / 68) & 3, b = item / 272;
    const int n0 = cn * 64;
    {
      float ak[16];
#pragma unroll
      for (int j = 0; j < 16; ++j) ak[j] = 0.f;
#pragma unroll
      for (int t = 0; t < 4; ++t) {
        float x[16];
        unpack8(pk[t][0], x); unpack8(pk[t][1], x + 8);
#pragma unroll
        for (int j = 0; j < 16; ++j) ak[j] += CWA[(h * 4 + t) * 128 + 16 * sp + j] * x[j];
      }
      float sk = 0.f;
#pragma unroll
      for (int j = 0; j < 16; ++j) { ak[j] = siluf_(ak[j]); sk += ak[j] * ak[j]; }
      sk = oct_sum(sk);
      const float rk = rsqrtf(sk + 1e-6f);
#pragma unroll
      for (int j = 0; j < 16; ++j) ak[j] *= rk;
      *(uint4*)(Ks + si * 136 + 16 * sp) = pack8(ak); *(uint4*)(Ks + si * 136 + 16 * sp + 8) = pack8(ak + 8);
    }
    const float gbv = pgb, gav = pga;
    if (item + (int)gridDim.x < 8 * 4 * 68) PREP_LOAD(item + (int)gridDim.x);
    if (wave < 2) {
      const int dir = wave;
      const int n = dir ? (n0 + 63 - lane) : (n0 + lane);
      const float aexp = __expf(p.in[23][(o_ * 2 + dir) * 4 + h]);
      const float dtb = p.in[24][(o_ * 2 + dir) * 4 + h];
      const float beta = sigmoidf_(gbv);
      float v = wave_incl_scan(-aexp * softplusf_(gav + dtb));
      sm[(dir * 2 + 0) * 64 + lane] = beta;
      sm[(dir * 2 + 1) * 64 + lane] = v;
      const size_t gi = ((size_t)((b * 4 + h) * 2 + dir)) * NTB + n;
      gcg[gi] = v; btg[gi] = beta;
    }
    __syncthreads();
    {
      const int m0 = (wave >> 1) * 16, nn0 = (wave & 1) * 32;
      f32x4 acc[1][2]; acc[0][0] = (f32x4){0.f, 0.f, 0.f, 0.f}; acc[0][1] = acc[0][0];
      lds_mma<1, 2, 128>(Ks, 136, Ks, 136, m0, nn0, acc, lane);
#pragma unroll
      for (int j = 0; j < 2; ++j)
#pragma unroll
        for (int r = 0; r < 4; ++r) KK[(m0 + quad * 4 + r) * 68 + nn0 + j * 16 + l15] = acc[0][j][r];
    }
    __syncthreads();
    for (int idx = tid; idx < 2 * 4096; idx += NTHREADS) {
      const int dir = idx >> 12, is = (idx >> 6) & 63, js = idx & 63;
      const int in_ = dir ? 63 - is : is, jn = dir ? 63 - js : js;
      float val = 0.f;
      if (js < is) val = sm[(dir * 2) * 64 + is] * KK[in_ * 68 + jn] * __expf(sm[(dir * 2 + 1) * 64 + is] - sm[(dir * 2 + 1) * 64 + js]);
      Mf[(dir * 64 + is) * 68 + (js & 3) * 16 + (js >> 2)] = val;
    }
    __syncthreads();
    {
      const int dir = tid >> 8, col = (tid & 255) >> 2, q = tid & 3;
      const float* M = Mf + dir * 64 * 68 + q * 16;
      bf16_t* obp = (bf16_t*)(p.ws + (dir ? OFF_BUFA : OFF_BUFB)) + (size_t)b * NTB * DM + 512 + h * 128 + col;
      float xo[16], mc[16], mn[16];
#pragma unroll
      for (int m = 0; m < 16; ++m) { xo[m] = 0.f; mc[m] = 0.f; mn[m] = 0.f; }
#pragma unroll
      for (int i = 0; i < 64; ++i) {
        if (i < 63) {
#pragma unroll
          for (int m4 = 0; m4 <= (i >> 4); ++m4) *(float4*)(mn + 4 * m4) = *(const float4*)(M + (i + 1) * 68 + 4 * m4);
        }
        float part = 0.f;
        if (i > 0) {
#pragma unroll
          for (int m = 0; m <= ((i - 1) >> 2); ++m) part += mc[m] * xo[m];
        }
        part = quad_sum(part);
        const float xi = ((i == col) ? 1.f : 0.f) - part;
        if ((i & 3) == q) xo[i >> 2] = xi;
        if (q == 0) {
          const int n = dir ? (n0 + 63 - i) : (n0 + i);
          const bf16_t xb = f2bf(xi);
          obp[(size_t)n * DM] = xb; obp[(size_t)n * DM + 64] = xb;
        }
#pragma unroll
        for (int m = 0; m < 16; ++m) mc[m] = mn[m];
      }
    }
    __syncthreads();
  }
}

#undef PREP_LOAD
__device__ __forceinline__ void cgdn(const Params& p, int layer, int item, char* lds) {
  const int tid = otid(), lane = tid & 63, wave = tid >> 6, l15 = lane & 15, quad = lane >> 4;
  const int b = item >> 4, h = (item >> 2) & 3, dir = (item >> 1) & 1, vs = item & 1;
  const int o_ = layer >> 1;
  const bf16_t* proj = (const bf16_t*)(p.ws + OFF_BIG);
  bf16_t* ob = (bf16_t*)(p.ws + (dir ? OFF_BUFA : OFF_BUFB));
  const float* gcg = (const float*)(p.ws + OFF_GC) + ((size_t)((b * 4 + h) * 2 + dir)) * NTB;
  const float* btg = (const float*)(p.ws + OFF_BETA) + ((size_t)((b * 4 + h) * 2 + dir)) * NTB;
  bf16_t* Qs = (bf16_t*)lds;
  bf16_t* Ks = Qs + 64 * 136;
  bf16_t* KT = Ks + 64 * 136;
  bf16_t* Ks2 = KT + 128 * 72;
  bf16_t* Tm = Ks2 + 64 * 136;
  bf16_t* PQ = Tm + 64 * 72;
  bf16_t* VB = PQ + 64 * 200;
  bf16_t* V2T = VB + 64 * 200;
  bf16_t* RT = V2T + 64 * 72;
  float* CW = (float*)(RT + 64 * 72);
  float* gcs = CW + 4 * 320;
  float* e2 = gcs + 64;
  for (int i = tid; i < 4 * 320; i += NTHREADS) {
    const int t = i / 320, cc = i % 320;
    const int ch = cc < 128 ? (h * 128 + cc) : cc < 256 ? (512 + h * 128 + cc - 128) : (1024 + h * 128 + vs * 64 + cc - 256);
    CW[i] = p.in[22][((size_t)o_ * 4 + t) * 1536 + ch];
  }
  for (int i = tid; i < 64 * 128; i += NTHREADS) VB[(i >> 7) * 200 + 64 + (i & 127)] = 0;
  f32x4 S[1][4];
#pragma unroll
  for (int j = 0; j < 4; ++j) S[0][j] = (f32x4){0.f, 0.f, 0.f, 0.f};
  const int si = tid >> 3, sp = tid & 7;
  const int tp = tid >> 4, cg = tid & 15;
  const int m0 = (wave >> 1) * 16, n0 = (wave & 1) * 32;
  uint4 rq[5], rk[5], rtt; uint2 rv[5]; float rg0, rg1, rb0, rb1, rgl;
#define GDN_LOAD(cc) do { \
    const int na_ = scan2nat((cc) * 64 + 2 * tp, dir); \
    const int nlo_ = dir ? na_ - 1 : na_; \
    const int lo_ = nlo_ < 256 ? 0 : 256, hi_ = nlo_ < 256 ? 256 : NTB; \
    const int nb_ = dir ? na_ - 1 : na_ + 1; \
    rg0 = gcg[na_]; rg1 = gcg[nb_]; rb0 = btg[na_]; rb1 = btg[nb_]; rgl = gcg[scan2nat((cc) * 64 + 63, dir)]; \
    rtt = *(const uint4*)(ob + ((size_t)b * NTB + scan2nat((cc) * 64 + si, dir)) * DM + 512 + h * 128 + vs * 64 + 8 * sp); \
    _Pragma("unroll") for (int k = 0; k < 5; ++k) { \
      const int nn = nlo_ - 2 + k; \
      const bool ok = (nn >= lo_ && nn < hi_); \
      const bf16_t* rr = proj + ((size_t)b * NTB + (ok ? nn : nlo_)) * OD_IN; \
      const uint4 a_ = *(const uint4*)(rr + 2560 + h * 128 + 8 * cg); \
      const uint4 b_ = *(const uint4*)(rr + 3072 + h * 128 + 8 * cg); \
      const uint2 c_ = *(const uint2*)(rr + 3584 + h * 128 + vs * 64 + 4 * cg); \
      rq[k] = ok ? a_ : make_uint4(0u, 0u, 0u, 0u); rk[k] = ok ? b_ : make_uint4(0u, 0u, 0u, 0u); rv[k] = ok ? c_ : make_uint2(0u, 0u); } } while (0)
  GDN_LOAD(0);
  __syncthreads();
  for (int c = 0; c < 68; ++c) {
    float gl;
    {
      gl = rgl;
      const float gc0 = rg0, gc1 = rg1, bi0 = rb0, bi1 = rb1;
      *(uint4*)(Tm + si * 72 + 8 * sp) = rtt;
      const int i0 = 2 * tp, i1 = 2 * tp + 1;
      const float eg0 = __expf(gc0), eg1 = __expf(gc1), kb0 = bi0 * eg0, kb1 = bi1 * eg1;
      {
        float aL[8], aH[8];
#pragma unroll
        for (int j = 0; j < 8; ++j) { aL[j] = 0.f; aH[j] = 0.f; }
#pragma unroll
        for (int k = 0; k < 5; ++k) {
          float x[8]; unpack8(rq[k], x);
          if (k < 4) {
#pragma unroll
            for (int j = 0; j < 8; ++j) aL[j] += CW[k * 320 + 8 * cg + j] * x[j];
          }
          if (k > 0) {
#pragma unroll
            for (int j = 0; j < 8; ++j) aH[j] += CW[(k - 1) * 320 + 8 * cg + j] * x[j];
          }
        }
        float sL = 0.f, sH = 0.f;
#pragma unroll
        for (int j = 0; j < 8; ++j) { aL[j] = siluf_(aL[j]); aH[j] = siluf_(aH[j]); sL += aL[j] * aL[j]; sH += aH[j] * aH[j]; }
        sL = row16_sum(sL); sH = row16_sum(sH);
        const float rL = rsqrtf(sL + 1e-6f) * 0.08838834764831845f, rH = rsqrtf(sH + 1e-6f) * 0.08838834764831845f;
        float q0[8], q1[8];
#pragma unroll
        for (int j = 0; j < 8; ++j) { const float a_ = aL[j] * rL, b_ = aH[j] * rH; q0[j] = dir ? b_ : a_; q1[j] = dir ? a_ : b_; }
        *(uint4*)(Qs + i0 * 136 + 8 * cg) = pack8(q0); *(uint4*)(Qs + i1 * 136 + 8 * cg) = pack8(q1);
#pragma unroll
        for (int j = 0; j < 8; ++j) { q0[j] *= eg0; q1[j] *= eg1; }
        *(uint4*)(PQ + i0 * 200 + 64 + 8 * cg) = pack8(q0); *(uint4*)(PQ + i1 * 200 + 64 + 8 * cg) = pack8(q1);
      }
      asm volatile("" ::: "memory");
      {
        float aL[8], aH[8];
#pragma unroll
        for (int j = 0; j < 8; ++j) { aL[j] = 0.f; aH[j] = 0.f; }
#pragma unroll
        for (int k = 0; k < 5; ++k) {
          float x[8]; unpack8(rk[k], x);
          if (k < 4) {
#pragma unroll
            for (int j = 0; j < 8; ++j) aL[j] += CW[k * 320 + 128 + 8 * cg + j] * x[j];
          }
          if (k > 0) {
#pragma unroll
            for (int j = 0; j < 8; ++j) aH[j] += CW[(k - 1) * 320 + 128 + 8 * cg + j] * x[j];
          }
        }
        float sL = 0.f, sH = 0.f;
#pragma unroll
        for (int j = 0; j < 8; ++j) { aL[j] = siluf_(aL[j]); aH[j] = siluf_(aH[j]); sL += aL[j] * aL[j]; sH += aH[j] * aH[j]; }
        sL = row16_sum(sL); sH = row16_sum(sH);
        const float rL = rsqrtf(sL + 1e-6f), rH = rsqrtf(sH + 1e-6f);
        float k0[8], k1[8];
#pragma unroll
        for (int j = 0; j < 8; ++j) { const float a_ = aL[j] * rL, b_ = aH[j] * rH; k0[j] = dir ? b_ : a_; k1[j] = dir ? a_ : b_; }
        *(uint4*)(Ks + i0 * 136 + 8 * cg) = pack8(k0); *(uint4*)(Ks + i1 * 136 + 8 * cg) = pack8(k1);
#pragma unroll
        for (int j = 0; j < 8; ++j) *(unsigned*)(KT + (8 * cg + j) * 72 + i0) = pack2(k0[j], k1[j]);
#pragma unroll
        for (int j = 0; j < 8; ++j) { k0[j] *= kb0; k1[j] *= kb1; }
        *(uint4*)(Ks2 + i0 * 136 + 8 * cg) = pack8(k0); *(uint4*)(Ks2 + i1 * 136 + 8 * cg) = pack8(k1);
      }
      asm volatile("" ::: "memory");
      {
        float aL[4], aH[4];
#pragma unroll
        for (int j = 0; j < 4; ++j) { aL[j] = 0.f; aH[j] = 0.f; }
#pragma unroll
        for (int k = 0; k < 5; ++k) {
          float x[4];
          x[0] = __uint_as_float(rv[k].x << 16); x[1] = __uint_as_float(rv[k].x & 0xffff0000u);
          x[2] = __uint_as_float(rv[k].y << 16); x[3] = __uint_as_float(rv[k].y & 0xffff0000u);
          if (k < 4) {
#pragma unroll
            for (int j = 0; j < 4; ++j) aL[j] += CW[k * 320 + 256 + 4 * cg + j] * x[j];
          }
          if (k > 0) {
#pragma unroll
            for (int j = 0; j < 4; ++j) aH[j] += CW[(k - 1) * 320 + 256 + 4 * cg + j] * x[j];
          }
        }
#pragma unroll
        for (int j = 0; j < 4; ++j) {
          const float a_ = siluf_(aL[j]), b_ = siluf_(aH[j]);
          *(unsigned*)(VB + (4 * cg + j) * 200 + i0) = pack2((dir ? b_ : a_) * bi0, (dir ? a_ : b_) * bi1);
        }
      }
      asm volatile("" ::: "memory");
      if (c + 1 < 68) GDN_LOAD(c + 1);
      if (cg == 0) { gcs[i0] = gc0; gcs[i1] = gc1; e2[i0] = __expf(gl - gc0); e2[i1] = __expf(gl - gc1); }
    }
    __syncthreads();
    {
      f32x4 a2[1][2];
      a2[0][0] = (f32x4){0.f, 0.f, 0.f, 0.f}; a2[0][1] = a2[0][0];
      lds_mma<1, 2, 128>(Qs, 136, Ks, 136, m0, n0, a2, lane);
#pragma unroll
      for (int j = 0; j < 2; ++j)
#pragma unroll
        for (int r = 0; r < 4; ++r) {
          const int i = m0 + quad * 4 + r, jj = n0 + j * 16 + l15;
          PQ[i * 200 + jj] = f2bf((i >= jj) ? a2[0][j][r] * __expf(gcs[i] - gcs[jj]) : 0.f);
        }
      f32x4 pa[1][2];
      pa[0][0] = (f32x4){0.f, 0.f, 0.f, 0.f}; pa[0][1] = pa[0][0];
      lds_mma<1, 2, 128>(Ks2, 136, VB + 64, 200, m0, n0, pa, lane);
#pragma unroll
      for (int j = 0; j < 2; ++j) {
        const int v = n0 + j * 16 + l15, j0 = m0 + quad * 4;
        const uint2 vb = *(const uint2*)(VB + v * 200 + j0);
        const float v0 = __uint_as_float(vb.x << 16), v1 = __uint_as_float(vb.x & 0xffff0000u);
        const float v2 = __uint_as_float(vb.y << 16), v3 = __uint_as_float(vb.y & 0xffff0000u);
        uint2 o; o.x = pack2(v0 - pa[0][j][0], v1 - pa[0][j][1]); o.y = pack2(v2 - pa[0][j][2], v3 - pa[0][j][3]);
        *(uint2*)(RT + v * 72 + j0) = o;
      }
    }
    __syncthreads();
    {
      f32x4 acc[1][2]; acc[0][0] = (f32x4){0.f, 0.f, 0.f, 0.f}; acc[0][1] = acc[0][0];
      lds_mma<1, 2, 64>(Tm, 72, RT, 72, m0, n0, acc, lane);
#pragma unroll
      for (int j = 0; j < 2; ++j) {
        const int v = n0 + j * 16 + l15, i0 = m0 + quad * 4;
        uint2 o; o.x = pack2(acc[0][j][0], acc[0][j][1]); o.y = pack2(acc[0][j][2], acc[0][j][3]);
        *(uint2*)(VB + v * 200 + i0) = o;
        uint2 o2; o2.x = pack2(acc[0][j][0] * e2[i0], acc[0][j][1] * e2[i0 + 1]); o2.y = pack2(acc[0][j][2] * e2[i0 + 2], acc[0][j][3] * e2[i0 + 3]);
        *(uint2*)(V2T + v * 72 + i0) = o2;
      }
    }
    __syncthreads();
    {
      f32x4 acc[1][2]; acc[0][0] = (f32x4){0.f, 0.f, 0.f, 0.f}; acc[0][1] = acc[0][0];
      lds_mma<1, 2, 192>(PQ, 200, VB, 200, m0, n0, acc, lane);
#pragma unroll
      for (int r = 0; r < 4; ++r) {
        const int i = m0 + quad * 4 + r;
        const int n = scan2nat(c * 64 + i, dir);
        bf16_t* orow = ob + ((size_t)b * NTB + n) * DM + 512 + h * 128 + vs * 64 + n0 + l15;
        orow[0] = f2bf(acc[0][0][r]); orow[16] = f2bf(acc[0][1][r]);
      }
    }
    {
      const float ge = __expf(gl);
#pragma unroll
      for (int j = 0; j < 4; ++j) S[0][j] *= ge;
      lds_mma<1, 4, 64>(KT, 72, V2T, 72, wave * 16, 0, S, lane);
    }
    __syncthreads();
#pragma unroll
    for (int j = 0; j < 4; ++j) {
      const int v = j * 16 + l15, d = wave * 16 + quad * 4;
      uint2 uu; uu.x = pack2(S[0][j][0], S[0][j][1]); uu.y = pack2(S[0][j][2], S[0][j][3]);
      *(uint2*)(VB + v * 200 + 64 + d) = uu;
    }
  }
  __syncthreads();
}

#ifndef NAIVE_EVEN
#define NAIVE_EVEN 0
#endif
#ifndef NAIVE_ODD
#define NAIVE_ODD 0
#endif
__device__ __forceinline__ void chains_phase(const Params& p, int layer, char* lds) {
  const int wave = threadIdx.x >> 6;
  float* wl = (float*)(lds + wave * 2048);
  const int item = blockIdx.x + gridDim.x * wave;
  if (layer & 1) {
#if NAIVE_ODD
    if (item >= 512) { chain_idle(); return; }
    if (item < 256) chain_gla(p, layer, item, wl); else chain_gdn(p, layer, item - 256, wl);
#else
    for (int it = blockIdx.x; it < 256; it += gridDim.x) {
      if (it < 128) cgla(p, layer, it, lds); else cgdn(p, layer, it - 128, lds);
    }
#endif
  } else {
#if NAIVE_EVEN
    if (item >= 384) { chain_idle(); return; }
    if (item < 128) chain_ret(p, layer, item, wl); else chain_lru(p, layer, item - 128, wl);
#else
    for (int it = blockIdx.x; it < 256; it += gridDim.x) {
      if (it < 128) cret(p, layer, it, lds); else clru(p, layer, it - 128, lds);
    }
#endif
  }
}

__device__ __forceinline__ void combine_phase(const Params& p, int layer) {
  const int tid = otid(), lane = tid & 63, wave = __builtin_amdgcn_readfirstlane(tid >> 6);
  const int odd = layer & 1;
  const bf16_t* proj = (const bf16_t*)(p.ws + OFF_BIG);
  bf16_t* zf = (bf16_t*)(p.ws + OFF_BUFB);
  const bf16_t* zr = (const bf16_t*)(p.ws + OFF_BUFA);
  const int ldp = odd ? OD_IN : EV_IN;
#pragma unroll 1
  for (int u = blockIdx.x * 8 + wave; u < TT * 2; u += gridDim.x * 8) {
    const int g = u >> 1, hh = u & 1;
    const int c = hh * 512 + lane * 8;
    int gcol;
    if (!odd) gcol = hh ? (2048 + (c - 512)) : (512 + c);
    else gcol = hh ? (4096 + (c - 512)) : (2048 + c);
    const uint4 a4 = *(const uint4*)(zf + (size_t)g * DM + c);
    const uint4 b4 = *(const uint4*)(zr + (size_t)g * DM + c);
    const uint4 g4 = *(const uint4*)(proj + (size_t)g * ldp + gcol);
    float o[8], gt[8], y[8];
    unpack8(a4, o); unpack8(b4, y); unpack8(g4, gt);
#pragma unroll
    for (int j = 0; j < 8; ++j) o[j] += y[j];
    if (!odd && hh == 0) {
#pragma unroll
      for (int j = 0; j < 8; ++j) y[j] = o[j] * gelu_tanh(gt[j]);
    } else {
      if (!odd) {
        float s = 0.f;
#pragma unroll
        for (int j = 0; j < 8; ++j) s += o[j];
        s = row16_sum(s);
        const float mean = s * (1.f / 128.f);
#pragma unroll
        for (int j = 0; j < 8; ++j) o[j] -= mean;
      }
      float ss = 0.f;
#pragma unroll
      for (int j = 0; j < 8; ++j) ss += o[j] * o[j];
      ss = row16_sum(ss);
      const float rs = rsqrtf(ss * (1.f / 128.f) + 1e-6f);
#pragma unroll
      for (int j = 0; j < 8; ++j) y[j] = o[j] * rs * siluf_(gt[j]);
    }
    *(uint4*)(zf + (size_t)g * DM + c) = pack8(y);
  }
}

#define XB_TMO      128
#define XB_XCNT(j)  (256  + 64 * (j))
#define XB_XSUB(j)  (1280 + 64 * (j))
#define XB_XGEN(j)  (2304 + 64 * (j))
#define XB_TOP      3328
#define XB_TOPGEN   3392
#define XCD_BAR_WORDS 3456
#define XB_SPIN_CAP (1u << 18)
#define LAS __attribute__((address_space(3)))
#define OFF_BAR 508755968ull
__device__ __forceinline__ unsigned xb_ld(unsigned* p)              { return __hip_atomic_load(p, __ATOMIC_RELAXED, __HIP_MEMORY_SCOPE_AGENT); }
__device__ __forceinline__ unsigned xb_add(unsigned* p, unsigned v) { return __hip_atomic_fetch_add(p, v, __ATOMIC_RELAXED, __HIP_MEMORY_SCOPE_AGENT); }
__device__ __forceinline__ unsigned xb_xcc_id() { return (unsigned)__builtin_amdgcn_s_getreg((3 << 11) | 20) & 0xFu; }
#define XB_SPIN(cond, bar) do { unsigned _sp = 0; while (cond) { __builtin_amdgcn_s_sleep(1); \
    if ((++_sp & 255u) == 0u) { if (xb_ld(&(bar)[XB_TMO])) break; if (_sp > XB_SPIN_CAP) { atomicAdd(&(bar)[XB_TMO], 1u); break; } } } } while (0)
struct XcdBarrier { unsigned* bar; unsigned x; volatile LAS unsigned* st; };
__device__ __forceinline__ XcdBarrier xcd_barrier_post(unsigned* bar, volatile LAS unsigned* st) {
  XcdBarrier b; b.bar = bar; b.x = xb_xcc_id(); b.st = st;
  if (threadIdx.x == 0) (void)xb_add(&bar[XB_XCNT(b.x)], 1u);
  return b;
}
__device__ __forceinline__ void xcd_barrier_complete(unsigned* bar, unsigned x, unsigned& nloc, unsigned& nx) {
  const unsigned G = gridDim.x * gridDim.y * gridDim.z;
  unsigned sum, cnt, mine, sp = 0u;
  for (;;) {
    sum = 0u; cnt = 0u; mine = 0u;
#pragma unroll
    for (unsigned j = 0; j < 16; ++j) { const unsigned c = xb_ld(&bar[XB_XCNT(j)]); sum += c; cnt += (c > 0u) ? 1u : 0u; mine = (j == x) ? c : mine; }
    if (sum == G) break;
    __builtin_amdgcn_s_sleep(1);
    if ((++sp & 255u) == 0u) { if (xb_ld(&bar[XB_TMO])) break; if (sp > XB_SPIN_CAP) { atomicAdd(&bar[XB_TMO], 1u); break; } }
  }
  nloc = mine > 0u ? mine : 1u; nx = cnt > 0u ? cnt : 1u;
}
__device__ __forceinline__ void xcd_barrier_(const XcdBarrier& b) {
  asm volatile("s_waitcnt vmcnt(0)" ::: "memory");
  __syncthreads();
  if (threadIdx.x == 0) {
    unsigned* bar = b.bar;
    __builtin_amdgcn_s_waitcnt(0);
    unsigned nloc = b.st[0], nx = b.st[1];
    if (nloc == 0u) { xcd_barrier_complete(bar, b.x, nloc, nx); b.st[0] = nloc; b.st[1] = nx; }
    const unsigned old = xb_add(&bar[XB_XSUB(b.x)], 1u);
    const unsigned gen = old / nloc;
    if (old + 1u == (gen + 1u) * nloc) {
      __builtin_amdgcn_fence(__ATOMIC_RELEASE, "agent");
      asm volatile("s_waitcnt vmcnt(0)" ::: "memory");
      const unsigned og = xb_add(&bar[XB_TOP], 1u);
      const unsigned tg = og / nx;
      if (og + 1u == (tg + 1u) * nx) xb_add(&bar[XB_TOPGEN], 1u);
      else XB_SPIN(xb_ld(&bar[XB_TOPGEN]) == tg, bar);
      __builtin_amdgcn_fence(__ATOMIC_ACQUIRE, "agent");
      xb_add(&bar[XB_XGEN(b.x)], 1u);
      asm volatile("s_waitcnt vmcnt(0)" ::: "memory");
    } else {
      XB_SPIN(xb_ld(&bar[XB_XGEN(b.x)]) == gen, bar);
      __builtin_amdgcn_fence(__ATOMIC_ACQUIRE, "agent");
      asm volatile("s_waitcnt vmcnt(0)" ::: "memory");
    }
  }
  __syncthreads();
}

__device__ __forceinline__ void xcd_barrier(const Params& p, char* lds) {
  XcdBarrier b; b.bar = (unsigned*)(p.ws + OFF_BAR); b.x = xb_xcc_id(); b.st = (volatile LAS unsigned*)(LAS char*)(lds + LDS_BYTES - 16);
  xcd_barrier_(b);
}

__global__ void __launch_bounds__(NTHREADS) mega(Params p) {
  extern __shared__ __attribute__((aligned(16))) char lds[];
  cg::grid_group grid = cg::this_grid();
  volatile LAS unsigned* xst = (volatile LAS unsigned*)(LAS char*)(lds + LDS_BYTES - 16);
  if (threadIdx.x == 0) { xst[0] = 0u; xst[1] = 0u; }
  __syncthreads();
  (void)xcd_barrier_post((unsigned*)(p.ws + OFF_BAR), xst);
  phase0(p, lds);
  grid.sync();
  bf16_t* bufA = (bf16_t*)(p.ws + OFF_BUFA);
  bf16_t* bufB = (bf16_t*)(p.ws + OFF_BUFB);
  bf16_t* big = (bf16_t*)(p.ws + OFF_BIG);
  bf16_t* wb = (bf16_t*)(p.ws + OFF_W);
  for (int layer = 0; layer < 4; ++layer) {
    const float* mod = (const float*)(p.ws + OFF_MOD) + (size_t)layer * 9 * 6144;
    const int nin = (layer & 1) ? OD_IN : EV_IN;
    norm_phase(p, layer, 0);
    convert_weights(p, layer, lds);
    xcd_barrier(p, lds);
    gemm_phase<0>(p, bufA, DM, wb + WO_IN, nin, 1024, big, nin, nullptr, lds);
    xcd_barrier(p, lds);
    if (layer & 1) { gdn_prep_phase(p, layer, lds); xcd_barrier(p, lds); }
    chains_phase(p, layer, lds);
    xcd_barrier(p, lds);
    combine_phase(p, layer);
    xcd_barrier(p, lds);
    gemm_phase<2>(p, bufB, DM, wb + WO_OUT, 1024, 1024, nullptr, 0, mod + 2 * 1024, lds, layer == 0);
    xcd_barrier(p, lds);
    norm_phase(p, layer, 1);
    xcd_barrier(p, lds);
    gemm_phase<1>(p, bufA, DM, wb + WO_W1, DFF, 1024, big, DFF, nullptr, lds);
    xcd_barrier(p, lds);
    gemm_phase<2>(p, big, DFF, wb + WO_W2, 1024, 4096, nullptr, 0, mod + 5 * 1024, lds);
    xcd_barrier(p, lds);
  }
  final_norm(p);
}

extern "C" void kernel_launch(void* const* d_in, const int* in_sizes, int n_in, void* d_out, int out_size, void* d_ws, size_t ws_size,
                              hipStream_t stream) {
  static int grid_blocks = 0;
  if (!grid_blocks) {
    int dev = 0, cus = 0, per_cu = 0;
    hipGetDevice(&dev);
    hipDeviceGetAttribute(&cus, hipDeviceAttributeMultiprocessorCount, dev);
    hipFuncSetAttribute((const void*)mega, hipFuncAttributeMaxDynamicSharedMemorySize, LDS_BYTES);
    hipOccupancyMaxActiveBlocksPerMultiprocessor(&per_cu, (const void*)mega, NTHREADS, LDS_BYTES);
    if (per_cu < 1) per_cu = 1;
    if (per_cu > 1) per_cu = 1;
    if (cus < 1) cus = 256;
    grid_blocks = cus * per_cu;
  }
  Params p{};
  for (int i = 0; i < 26; ++i) p.in[i] = (const float*)d_in[i];
  p.out = (float*)d_out;
  p.ws = (unsigned char*)d_ws;
  (void)hipMemsetAsync((char*)d_ws + OFF_BAR, 0, XCD_BAR_WORDS * 4, stream);
  void* args[] = {&p};
  hipError_t e = hipLaunchCooperativeKernel((const void*)mega, dim3(grid_blocks), dim3(NTHREADS), args, LDS_BYTES, stream);
  if (e != hipSuccess) fprintf(stderr, "cooperative launch failed: %s (grid %d)\n", hipGetErrorString(e), grid_blocks);
}
```
